# Optimizing an MI355X kernel written in HIP

```python
import jax
import jax.numpy as jnp
from jax import lax
import numpy as np

D_MODEL = 2048
BATCH = 2
SEQ = 4096
DEPTH = 2

D_PLE = 256
D_FF = 5632
EPS = 1e-6

SG_HEADS = 8
SG_HEAD_DIM = 128
SG_WIDTH = SG_HEADS * SG_HEAD_DIM
SG_CHUNK = 128

GLA_HEADS = 4
GLA_DK = 128
GLA_DV = 256
GLA_KW = GLA_HEADS * GLA_DK
GLA_VW = GLA_HEADS * GLA_DV
GLA_GATE_RANK = 16
GLA_GATE_TAU = 16.0
GLA_CHUNK = 64

MIX_WIDTH = SG_WIDTH + GLA_VW
IN_WIDTH = 2 * SG_WIDTH + 2 * GLA_KW + 2 * GLA_VW + GLA_GATE_RANK
MIX_SPLITS = (SG_WIDTH, 2 * SG_WIDTH, 2 * SG_WIDTH + GLA_KW, 2 * SG_WIDTH + 2 * GLA_KW,
              2 * SG_WIDTH + 2 * GLA_KW + GLA_VW, 2 * SG_WIDTH + 2 * GLA_KW + 2 * GLA_VW)

kernel_name = 'hybrid_sgmlp_gla_macaron_ple'


def rms_norm(x, g):
    xf = x.astype(jnp.float32)
    y = xf * lax.rsqrt(jnp.mean(xf * xf, axis=-1, keepdims=True) + EPS)
    return (y * g.astype(jnp.float32)).astype(x.dtype)


def layer_norm(x, g):
    xf = x.astype(jnp.float32)
    xc = xf - jnp.mean(xf, axis=-1, keepdims=True)
    y = xc * lax.rsqrt(jnp.mean(xc * xc, axis=-1, keepdims=True) + EPS)
    return (y * g.astype(jnp.float32)).astype(x.dtype)


def swiglu_ffn(x, w_in, w_out):
    gate, up = jnp.split(x @ w_in, 2, axis=-1)
    return (jax.nn.silu(gate) * up) @ w_out


def chunked_spatial_gating(u, v, v_gain, w_s, b_s):
    bsz, t_len, _ = u.shape
    n_chunks = t_len // SG_CHUNK
    u = u.reshape(bsz, n_chunks, SG_CHUNK, SG_HEADS, SG_HEAD_DIM)
    v = v.reshape(bsz, n_chunks, SG_CHUNK, SG_HEADS, SG_HEAD_DIM)
    v = layer_norm(v, v_gain.reshape(SG_HEADS, SG_HEAD_DIM))
    causal = jnp.tril(jnp.ones((SG_CHUNK, SG_CHUNK), dtype=bool))
    w = jnp.where(causal, w_s, jnp.zeros_like(w_s))
    mixed = jnp.einsum('hts,bnshd->bnthd', w, v) + b_s.T[None, None, :, :, None]
    return (u * mixed).reshape(bsz, t_len, SG_WIDTH)


def gla_chunked(q, k, v, log_a):
    out_dtype = v.dtype
    bsz, n_heads, t_len, dk = q.shape
    dv = v.shape[-1]
    n_chunks = t_len // GLA_CHUNK

    def to_chunks(t):
        t = t.astype(jnp.float32).reshape(bsz, n_heads, n_chunks, GLA_CHUNK, t.shape[-1])
        return jnp.moveaxis(t, 2, 0)

    qc, kc, vc, gc = to_chunks(q), to_chunks(k), to_chunks(v), to_chunks(log_a)
    causal = jnp.tril(jnp.ones((GLA_CHUNK, GLA_CHUNK), dtype=bool))[:, :, None]

    def step(state, inp):
        qi, ki, vi, gi = inp
        b = jnp.cumsum(gi, axis=2)
        o_inter = jnp.einsum('bhck,bhkv->bhcv', qi * jnp.exp(b), state)
        rel = jnp.where(causal, b[:, :, :, None, :] - b[:, :, None, :, :], -jnp.inf)
        scores = jnp.einsum('bhik,bhjk,bhijk->bhij', qi, ki, jnp.exp(rel))
        o = o_inter + jnp.einsum('bhij,bhjv->bhiv', scores, vi)
        b_last = b[:, :, -1:, :]
        k_dec = ki * jnp.exp(b_last - b)
        new_state = state * jnp.exp(b_last)[:, :, 0, :, None] + jnp.einsum('bhck,bhcv->bhkv', k_dec, vi)
        return new_state, o

    state0 = jnp.zeros((bsz, n_heads, dk, dv), jnp.float32)
    _, o = lax.scan(step, state0, (qc, kc, vc, gc))
    return jnp.moveaxis(o, 0, 2).reshape(bsz, n_heads, t_len, dv).astype(out_dtype)


def gla_mixer(q, k, v, r, z, w_gate, b_gate, o_gain):
    bsz, t_len, _ = q.shape
    log_a = jax.nn.log_sigmoid((z @ w_gate + b_gate).astype(jnp.float32)) / GLA_GATE_TAU

    def heads(t, d):
        return t.reshape(bsz, t_len, GLA_HEADS, d).transpose(0, 2, 1, 3)

    o = gla_chunked(heads(q * GLA_DK ** -0.5, GLA_DK), heads(k, GLA_DK),
                    heads(v, GLA_DV), heads(log_a, GLA_DK))
    o = o.transpose(0, 2, 1, 3)
    o = rms_norm(o, o_gain.reshape(GLA_HEADS, GLA_DV))
    return o.reshape(bsz, t_len, GLA_VW) * jax.nn.silu(r)


def setup_inputs(seed: int = 0) -> dict:
    key = jax.random.key(seed)
    ks = jax.random.split(key, 24)
    f32 = jnp.float32
    L, D = DEPTH, D_MODEL

    def normal(k, shape, scale):
        return jax.random.normal(k, shape, f32) * scale

    def gain(k, shape):
        return 1.0 + 0.05 * jax.random.normal(k, shape, f32)

    return {
        'x': normal(ks[0], (BATCH, SEQ, D), 1.0),
        'p': normal(ks[1], (DEPTH, BATCH, SEQ, D_PLE), 1.0),
        'ffn1_norm': gain(ks[2], (L, D)),
        'w_ffn1_in': normal(ks[3], (L, D, 2 * D_FF), D ** -0.5),
        'w_ffn1_out': normal(ks[4], (L, D_FF, D), D_FF ** -0.5),
        'mix_norm': gain(ks[5], (L, D)),
        'w_mix_in': normal(ks[6], (L, D, IN_WIDTH), D ** -0.5),
        'sg_v_gain': gain(ks[7], (L, SG_WIDTH)),
        'sg_w': normal(ks[8], (L, SG_HEADS, SG_CHUNK, SG_CHUNK), 0.5 * SG_CHUNK ** -0.5),
        'sg_b': 1.0 + normal(ks[9], (L, SG_HEADS, SG_CHUNK), 0.1),
        'gla_w_gate': normal(ks[10], (L, GLA_GATE_RANK, GLA_KW), GLA_GATE_RANK ** -0.5),
        'gla_b_gate': normal(ks[11], (L, GLA_KW), 0.1),
        'gla_o_gain': gain(ks[12], (L, GLA_VW)),
        'w_mix_out': normal(ks[13], (L, MIX_WIDTH, D), MIX_WIDTH ** -0.5),
        'ffn2_norm': gain(ks[14], (L, D)),
        'w_ffn2_in': normal(ks[15], (L, D, 2 * D_FF), D ** -0.5),
        'w_ffn2_out': normal(ks[16], (L, D_FF, D), D_FF ** -0.5),
        'ple_norm': gain(ks[17], (L, D)),
        'w_ple_gate': normal(ks[18], (L, D, D), D ** -0.5),
        'w_ple_proj': normal(ks[19], (L, D_PLE, D), D_PLE ** -0.5),
        'final_norm': gain(ks[20], (D,)),
    }


def reference(x, p, ffn1_norm, w_ffn1_in, w_ffn1_out, mix_norm, w_mix_in, sg_v_gain, sg_w, sg_b,
              gla_w_gate, gla_b_gate, gla_o_gain, w_mix_out, ffn2_norm, w_ffn2_in, w_ffn2_out,
              ple_norm, w_ple_gate, w_ple_proj, final_norm):
    h = x
    for i in range(DEPTH):
        h = h + 0.5 * swiglu_ffn(rms_norm(h, ffn1_norm[i]), w_ffn1_in[i], w_ffn1_out[i])
        n = rms_norm(h, mix_norm[i])
        a_u, a_v, q, k, v, r, z = jnp.split(n @ w_mix_in[i], MIX_SPLITS, axis=-1)
        y_a = chunked_spatial_gating(jax.nn.gelu(a_u, approximate=False),
                                     jax.nn.gelu(a_v, approximate=False),
                                     sg_v_gain[i], sg_w[i], sg_b[i])
        y_b = gla_mixer(q, k, v, r, z, gla_w_gate[i], gla_b_gate[i], gla_o_gain[i])
        h = h + jnp.concatenate([y_a, y_b], axis=-1) @ w_mix_out[i]
        h = h + 0.5 * swiglu_ffn(rms_norm(h, ffn2_norm[i]), w_ffn2_in[i], w_ffn2_out[i])
        gate = jax.nn.sigmoid(rms_norm(h, ple_norm[i]) @ w_ple_gate[i])
        h = h + gate * (p[i] @ w_ple_proj[i])
    return rms_norm(h, final_norm)
```

```cpp
#include <hip/hip_runtime.h>
#include <hip/hip_cooperative_groups.h>
#include <cstdio>
#include <cstdint>
namespace cg = cooperative_groups;
#ifndef PROBE_SYNCS
#define PROBE_SYNCS 0
#endif
#ifndef PROBE_PRO
#define PROBE_PRO 0
#endif
#ifndef PROBE_MIX
#define PROBE_MIX 0
#endif
#ifndef PROBE_FFNIN
#define PROBE_FFNIN 0
#endif

#define LAS __attribute__((address_space(3)))
typedef unsigned short bf16_t;
typedef short bf16x8 __attribute__((ext_vector_type(8)));
typedef float f32x4 __attribute__((ext_vector_type(4)));
typedef float f32x2 __attribute__((ext_vector_type(2)));
typedef unsigned u32x4 __attribute__((ext_vector_type(4)));
typedef unsigned u32x2 __attribute__((ext_vector_type(2)));

constexpr int MTOK = 8192, DM = 2048, FF = 5632, NIN = 2 * FF, NMIX = 5136, NMIXP = 5376, MXW = 5120, DPLE = 256, SEQ = 4096;
constexpr float EPS = 1e-6f;
constexpr int NTHREADS = 512;
constexpr int LDS_BYTES = 137216;
constexpr int RSTD_OFF = 135168;

constexpr size_t SZ_W1I = (size_t)NIN * DM * 2, SZ_W1O = (size_t)DM * FF * 2, SZ_WMI = (size_t)NMIXP * DM * 2, SZ_WMO = (size_t)DM * DM * 2, SZ_WPG = (size_t)DM * DM * 2, SZ_WPP = (size_t)DM * DPLE * 2;
constexpr size_t OFF_W1I = 0, OFF_W1O = OFF_W1I + SZ_W1I, OFF_WMI = OFF_W1O + SZ_W1O, OFF_WMO = OFF_WMI + SZ_WMI, OFF_W2I = OFF_WMO + SZ_WMO, OFF_W2O = OFF_W2I + SZ_W1I,
                 OFF_WPG = OFF_W2O + SZ_W1O, OFF_WPP = OFF_WPG + SZ_WPG, SZ_LAYER = OFF_WPP + SZ_WPP;
constexpr size_t WS_HB = 2 * SZ_LAYER;
constexpr size_t WS_ACT = WS_HB + (size_t)MTOK * DM * 2;
constexpr size_t WS_MX = WS_ACT + (size_t)MTOK * FF * 2;
constexpr size_t WS_ZB = WS_MX + (size_t)MTOK * MXW * 2;
constexpr size_t WS_YM = WS_ZB + (size_t)MTOK * 16 * 4;
constexpr size_t WS_PP = WS_YM + (size_t)MTOK * DM * 2;
constexpr size_t WS_PB = WS_PP + (size_t)MTOK * DM * 2;
constexpr size_t WS_PARTA = WS_PB + (size_t)2 * MTOK * DPLE * 2;
constexpr size_t WS_PARTB = WS_PARTA + (size_t)MTOK * 32 * 4;
constexpr size_t WS_ST = WS_PARTB + (size_t)MTOK * 32 * 4;
constexpr size_t WS_DEC = WS_ST + (size_t)8 * 64 * 256 * 128 * 2;
constexpr size_t WS_HB2 = WS_DEC + (size_t)8 * 64 * 128 * 4;
constexpr size_t WS_QT = WS_HB2 + (size_t)MTOK * DM * 2;
constexpr size_t WS_BAR = WS_QT + (size_t)MTOK * 1024 * 2;
constexpr size_t BAR_BYTES = 16384;
constexpr size_t WS_END = WS_BAR + BAR_BYTES;
static_assert((size_t)8 * 64 * 256 * 128 * 4 <= (size_t)MTOK * FF * 2, "UT fits in ACT");

#define LDS_WAIT() asm volatile("s_waitcnt lgkmcnt(0)" ::: "memory")
__device__ __forceinline__ unsigned cvt_pk_bf16(float lo, float hi) { unsigned r; asm volatile("v_cvt_pk_bf16_f32 %0, %1, %2" : "=v"(r) : "v"(lo), "v"(hi)); return r; }
__device__ __forceinline__ float bf_lo(unsigned w) { return __uint_as_float(w << 16); }
__device__ __forceinline__ float bf_hi(unsigned w) { return __uint_as_float(w & 0xffff0000u); }
__device__ __forceinline__ float bf_one(bf16_t h) { return __uint_as_float(((unsigned)h) << 16); }
__device__ __forceinline__ bf16_t f2bf(float f) { return (bf16_t)(cvt_pk_bf16(f, 0.f) & 0xffffu); }
__device__ __forceinline__ float sigmoidf_(float x) { return __builtin_amdgcn_rcpf(1.0f + __expf(-x)); }
__device__ __forceinline__ float siluf_(float x) { return x * sigmoidf_(x); }
__device__ __forceinline__ int opaque_tid() { int t = threadIdx.x; asm volatile("" : "+v"(t)); return t; }
__device__ __forceinline__ float wave_sum(float v) {
#pragma unroll
    for (int o = 1; o < 64; o <<= 1) v += __shfl_xor(v, o);
    return v;
}
__device__ __forceinline__ f32x2 gelu_pk(f32x2 v) {
    const f32x2 av = __builtin_elementwise_abs(v), d = av * 0.2316418882f + 1.0f;
    f32x2 t; t.x = __builtin_amdgcn_rcpf(d.x); t.y = __builtin_amdgcn_rcpf(d.y);
    f32x2 q = t * 0.5307027145f + (-0.7265760135f); q = q * t + 0.7107068705f; q = q * t + (-0.142248368f); q = q * t + 0.127414796f; q = q * t;
    const f32x2 s = (v * v) * (-0.72134752044f);
    f32x2 e; e.x = __builtin_amdgcn_exp2f(s.x); e.y = __builtin_amdgcn_exp2f(s.y);
    const f32x2 m = v * (q * e), r = v - m;
    f32x2 o; o.x = v.x < 0.f ? m.x : r.x; o.y = v.y < 0.f ? m.y : r.y; return o;
}
__device__ __forceinline__ f32x4 gelu4(f32x4 v) { f32x2 a = gelu_pk((f32x2){v[0], v[1]}), b = gelu_pk((f32x2){v[2], v[3]}); return (f32x4){a.x, a.y, b.x, b.y}; }
__device__ __forceinline__ f32x4 silu4(f32x4 v) { return (f32x4){siluf_(v[0]), siluf_(v[1]), siluf_(v[2]), siluf_(v[3])}; }
__device__ __forceinline__ f32x4 sigm4(f32x4 v) { return (f32x4){sigmoidf_(v[0]), sigmoidf_(v[1]), sigmoidf_(v[2]), sigmoidf_(v[3])}; }
__device__ __forceinline__ u32x4 pack8(f32x4 a, f32x4 b) { u32x4 w; w.x = cvt_pk_bf16(a[0], a[1]); w.y = cvt_pk_bf16(a[2], a[3]); w.z = cvt_pk_bf16(b[0], b[1]); w.w = cvt_pk_bf16(b[2], b[3]); return w; }
__device__ __forceinline__ float row_rstd(const float* part, int row, int fq) {
    const f32x4* p = (const f32x4*)(part + (size_t)row * 32 + 8 * fq);
    const f32x4 a = p[0], b = p[1];
    float s = ((a[0] + a[1]) + (a[2] + a[3])) + ((b[0] + b[1]) + (b[2] + b[3]));
    s += __shfl_xor(s, 16); s += __shfl_xor(s, 32);
    return rsqrtf(s * (1.0f / DM) + EPS);
}

namespace pg8 {
constexpr int BM = 256, BK = 64, HALF = 128, HTB = HALF * BK * 2, STAGE_BYTES = 8 * HTB, NXCD = 8, WGM = 4;
__host__ __device__ __forceinline__ int lds_byte(int r, int c) { const int st = (r >> 4) * 2 + (c >> 5), rr = r & 15, cc = c & 31, ob = rr * 64 + cc * 2; return st * 1024 + (ob ^ (((ob >> 9) & 1) << 5)); }
__host__ __device__ __forceinline__ void stage_rc(int b, int& R, int& C) { const int st = b / 1024, sb = b % 1024, swz = sb ^ (((sb >> 9) & 1) << 5); R = (st >> 1) * 16 + swz / 64; C = (st & 1) * 32 + (swz % 64) / 2; }
__host__ __device__ __forceinline__ int perm32(int rho) { const int n = rho >> 4, i = rho & 15; return 8 * (i >> 2) + 4 * n + (i & 3); }
struct Unit { int pm, pn; };
struct Gemm { const bf16_t* A; const bf16_t* Bt; int M, N, K; };
struct StaticOrder {
    int nM, nN, nwg, G, c;
    __device__ void init(int M, int N, int G_, int c_) { nM = M / BM; nN = N / BM; nwg = nM * nN; G = G_; c = c_; }
    __device__ bool next(int i, Unit& u) const {
        const long L = (long)i * G + c; if (L >= nwg) return false;
        int wgid = (int)L; { const int q = nwg / NXCD, r = nwg % NXCD, xcd = wgid % NXCD, off = wgid / NXCD; wgid = (xcd < r ? xcd * (q + 1) : r * (q + 1) + (xcd - r) * q) + off; }
        const int nig = WGM * nN, gid = wgid / nig, fm = gid * WGM, gsz = (nM - fm) < WGM ? (nM - fm) : WGM;
        u.pm = fm + ((wgid % nig) % gsz); u.pn = (wgid % nig) / gsz; return true;
    }
};
struct NoPre { __device__ __forceinline__ void operator()() const {} };
template <class Epi, class Pre>
__device__ __forceinline__ void gemm_phase(LAS unsigned char* lds, const Gemm g, const StaticOrder& S, const Epi& E, const Pre& pre) {
    const int tid = opaque_tid(), wid = __builtin_amdgcn_readfirstlane(tid >> 6), lane = tid & 63, wr = wid >> 2, wc = wid & 3, fr = lane & 15, fq = lane >> 4;
    int K = g.K; asm volatile("" : "+s"(K)); const int nt = K / BK;
    unsigned voffA[2], voffB[2];
#pragma unroll
    for (int i = 0; i < 2; ++i) { int R, C; stage_rc(tid * 16 + i * 8192, R, C); const int Rb = (R & ~31) + perm32(R & 31);
        voffA[i] = (unsigned)(R * K + C) * 2u; voffB[i] = (unsigned)(Rb * K + C) * 2u; }
    const unsigned kstep = (unsigned)(BK * 2);
    const unsigned hstep = (unsigned)(HALF * 2) * (unsigned)K;
    const unsigned tstep = 2u * hstep;
    const __amdgpu_buffer_rsrc_t rA = __builtin_amdgcn_make_buffer_rsrc((void*)g.A, 0, 0x7ffffffc, 0x00020000), rB = __builtin_amdgcn_make_buffer_rsrc((void*)g.Bt, 0, 0x7ffffffc, 0x00020000);
    const unsigned ldsw = (unsigned)wid * 1024u;
    const int aoff = lds_byte(wr * 64 + fr, fq * 8), boff = lds_byte(wc * 32 + fr, fq * 8);
#define PG8_SA(b, h) (((b) * 2 + (h)) * HTB)
#define PG8_SB(b, h) ((4 + (b) * 2 + (h)) * HTB)
#define PG8_STAGE(bufoff, rsrc, soff, voff) do { const unsigned _so = (soff); _Pragma("unroll") for (int _i = 0; _i < 2; ++_i) \
        __builtin_amdgcn_raw_ptr_buffer_load_lds((rsrc), (LAS void*)(lds + (bufoff) + ldsw + _i * 8192), 16, (voff)[_i], _so, 0, 0); } while (0)
#define PG8_LDA(dst, b, h) do { _Pragma("unroll") for (int m = 0; m < 4; ++m) _Pragma("unroll") for (int k = 0; k < 2; ++k) dst[m][k] = *(const LAS bf16x8*)(lds + PG8_SA(b, h) + aoff + m * 2048 + k * 1024); } while (0)
#define PG8_LDB(dst, b, h) do { _Pragma("unroll") for (int n = 0; n < 2; ++n) _Pragma("unroll") for (int k = 0; k < 2; ++k) dst[n][k] = *(const LAS bf16x8*)(lds + PG8_SB(b, h) + boff + n * 2048 + k * 1024); } while (0)
#define PG8_MMA(ai, bj, At, Bt) do { __builtin_amdgcn_s_setprio(1); _Pragma("unroll") for (int m = 0; m < 4; ++m) _Pragma("unroll") for (int n = 0; n < 2; ++n) _Pragma("unroll") for (int k = 0; k < 2; ++k) \
        acc[ai][bj][m][n] = __builtin_amdgcn_mfma_f32_16x16x32_bf16(Bt[n][k], At[m][k], acc[ai][bj][m][n], 0, 0, 0); __builtin_amdgcn_s_setprio(0); } while (0)
#define PG8_WAIT_V(n) asm volatile("s_waitcnt vmcnt(" #n ")" ::: "memory")
#define PG8_WAIT_L(n) asm volatile("s_waitcnt lgkmcnt(" #n ")" ::: "memory")
#define PG8_BAR __builtin_amdgcn_s_barrier()
#define PG8_SCHED __builtin_amdgcn_sched_barrier(0)
    Unit cur, nxt; int ui = 0;
    if (!S.next(0, cur)) return;
    f32x4 acc[2][2][4][2];
#pragma unroll
    for (int a = 0; a < 2; ++a)
#pragma unroll
        for (int b = 0; b < 2; ++b)
#pragma unroll
            for (int m = 0; m < 4; ++m)
#pragma unroll
                for (int n = 0; n < 2; ++n) acc[a][b][m][n] = (f32x4){0.f, 0.f, 0.f, 0.f};
    bf16x8 At[4][2], B0[2][2], B1[2][2];
    unsigned oA = (unsigned)cur.pm * tstep, oB = (unsigned)cur.pn * tstep, ks = kstep;

    PG8_STAGE(PG8_SB(0, 0), rB, oB, voffB); PG8_STAGE(PG8_SB(0, 1), rB, oB + hstep, voffB); PG8_STAGE(PG8_SA(0, 0), rA, oA, voffA); PG8_STAGE(PG8_SA(0, 1), rA, oA + hstep, voffA);
    pre();
    if (wr == 1) PG8_BAR;
    PG8_WAIT_V(2); PG8_BAR;
    PG8_STAGE(PG8_SB(1, 0), rB, oB + kstep, voffB); PG8_STAGE(PG8_SA(1, 0), rA, oA + kstep, voffA); PG8_STAGE(PG8_SB(1, 1), rB, oB + hstep + kstep, voffB);
    PG8_WAIT_V(6); PG8_BAR;
    for (;;) {
        const bool has_next = S.next(ui + 1, nxt);
        const unsigned nks = has_next ? (0u - ks) : ks, nrev = (nks != kstep) ? (unsigned)(nt - 1) * kstep : 0u;
        const unsigned noA = has_next ? (unsigned)nxt.pm * tstep + nrev : oA, noB = has_next ? (unsigned)nxt.pn * tstep + nrev : oB;
        for (int t = 0; t < nt; t += 2) {
            const bool last = (t == nt - 2);
            const unsigned tk = (unsigned)t * ks;
            const unsigned a1 = oA + tk + ks;
            const unsigned a2 = last ? noA : oA + tk + 2u * ks, b2 = last ? noB : oB + tk + 2u * ks;
            const unsigned a3 = a2 + (last ? nks : ks), b3 = b2 + (last ? nks : ks);
            PG8_LDB(B0, 0, 0); PG8_LDB(B1, 0, 1); PG8_SCHED; PG8_LDA(At, 0, 0); PG8_STAGE(PG8_SA(1, 1), rA, a1 + hstep, voffA);
            PG8_WAIT_V(8); PG8_WAIT_L(0); PG8_BAR; PG8_MMA(0, 0, At, B0); PG8_MMA(0, 1, At, B1); PG8_BAR; PG8_SCHED;
            PG8_LDA(At, 0, 1); PG8_STAGE(PG8_SB(0, 0), rB, b2, voffB); PG8_STAGE(PG8_SB(0, 1), rB, b2 + hstep, voffB); PG8_STAGE(PG8_SA(0, 0), rA, a2, voffA);
            PG8_WAIT_V(8); PG8_WAIT_L(0); PG8_BAR; PG8_MMA(1, 0, At, B0); PG8_MMA(1, 1, At, B1); PG8_BAR; PG8_SCHED;
            PG8_LDB(B0, 1, 0); PG8_LDB(B1, 1, 1); PG8_SCHED; PG8_LDA(At, 1, 0); PG8_STAGE(PG8_SA(0, 1), rA, a2 + hstep, voffA);
            PG8_WAIT_V(8); PG8_WAIT_L(0); PG8_BAR; PG8_MMA(0, 0, At, B0); PG8_MMA(0, 1, At, B1); PG8_BAR; PG8_SCHED;
            PG8_LDA(At, 1, 1); PG8_STAGE(PG8_SB(1, 0), rB, b3, voffB); PG8_STAGE(PG8_SB(1, 1), rB, b3 + hstep, voffB); PG8_STAGE(PG8_SA(1, 0), rA, a3, voffA);
            PG8_WAIT_V(8); PG8_WAIT_L(0); PG8_BAR; PG8_MMA(1, 0, At, B0); PG8_MMA(1, 1, At, B1); PG8_BAR; PG8_SCHED;
        }
        if (wr == 0) PG8_BAR;
        E(acc, cur, wr, wc, fr, fq);
        if (!has_next) break;
#pragma unroll
        for (int a = 0; a < 2; ++a)
#pragma unroll
            for (int b = 0; b < 2; ++b)
#pragma unroll
                for (int m = 0; m < 4; ++m)
#pragma unroll
                    for (int n = 0; n < 2; ++n) acc[a][b][m][n] = (f32x4){0.f, 0.f, 0.f, 0.f};
        cur = nxt; oA = noA; oB = noB; ks = nks; ++ui;
        if (wr == 1) PG8_BAR;
    }
    PG8_WAIT_V(0);
    PG8_BAR;
#undef PG8_SA
#undef PG8_SB
#undef PG8_STAGE
#undef PG8_LDA
#undef PG8_LDB
#undef PG8_MMA
#undef PG8_WAIT_V
#undef PG8_WAIT_L
#undef PG8_BAR
#undef PG8_SCHED
}
}
using pg8::Unit;
typedef f32x4 AccT[2][2][4][2];

__device__ __forceinline__ void row_rstd8(const float* part, int row0, int fq, float (&rs)[2][4]) {
#pragma unroll
    for (int ai = 0; ai < 2; ++ai) {
        f32x4 pa[4], pb[4];
#pragma unroll
        for (int m = 0; m < 4; ++m) { const f32x4* p = (const f32x4*)(part + (unsigned)((row0 + ai * 128 + m * 16) * 32 + 8 * fq)); pa[m] = p[0]; pb[m] = p[1]; }
#pragma unroll
        for (int m = 0; m < 4; ++m) { const f32x4 a = pa[m], b = pb[m];
            float s = ((a[0] + a[1]) + (a[2] + a[3])) + ((b[0] + b[1]) + (b[2] + b[3]));
            s += __shfl_xor(s, 16); s += __shfl_xor(s, 32);
            rs[ai][m] = rsqrtf(s * (1.0f / DM) + EPS); }
    }
}
__device__ __forceinline__ void fill_rstd_table(LAS float* tab, const float* part, int pm) {
    const int tid = opaque_tid(), row = tid >> 1, half = tid & 1;
    const f32x4* p = (const f32x4*)(part + (unsigned)((pm * 256 + row) * 32 + 16 * half));
    const f32x4 a = p[0], b = p[1], c = p[2], d = p[3];
    float s = (((a[0] + a[1]) + (a[2] + a[3])) + ((b[0] + b[1]) + (b[2] + b[3]))) + (((c[0] + c[1]) + (c[2] + c[3])) + ((d[0] + d[1]) + (d[2] + d[3])));
    s += __shfl_xor(s, 1);
    if (half == 0) tab[row] = rsqrtf(s * (1.0f / DM) + EPS);
    __syncthreads();
}
struct TabPre {
    LAS float* tab; const float* part; int pm;
    __device__ __forceinline__ void operator()() const {
        const int tid = opaque_tid(), row = tid >> 1, half = tid & 1;
        const f32x4* p = (const f32x4*)(part + (unsigned)((pm * 256 + row) * 32 + 16 * half));
        const f32x4 a = p[0], b = p[1], c = p[2], d = p[3];
        float s = (((a[0] + a[1]) + (a[2] + a[3])) + ((b[0] + b[1]) + (b[2] + b[3]))) + (((c[0] + c[1]) + (c[2] + c[3])) + ((d[0] + d[1]) + (d[2] + d[3])));
        s += __shfl_xor(s, 1);
        if (half == 0) tab[row] = rsqrtf(s * (1.0f / DM) + EPS);
    }
};
__device__ __forceinline__ void row_scales(const float* part, const LAS float* tab, int pm0, int pm, int row0, int wr, int fr, int fq, float (&rs)[2][4]) {
    if (pm == pm0) {
#pragma unroll
        for (int ai = 0; ai < 2; ++ai)
#pragma unroll
            for (int m = 0; m < 4; ++m) rs[ai][m] = tab[ai * 128 + wr * 64 + m * 16 + fr];
    } else row_rstd8(part, row0, fq, rs);
}
__device__ __forceinline__ float sumsq8(f32x4 h0, f32x4 h1) { return ((h0[0] * h0[0] + h0[1] * h0[1]) + (h0[2] * h0[2] + h0[3] * h0[3])) + ((h1[0] * h1[0] + h1[1] * h1[1]) + (h1[2] * h1[2] + h1[3] * h1[3])); }
struct EpiSwiglu {
    bf16_t* act; const float* part; const LAS float* tab; int pm0;
    __device__ __forceinline__ void operator()(const AccT& acc, const Unit& u, int wr, int wc, int fr, int fq) const {
        const int row0 = u.pm * 256 + wr * 64 + fr, col0 = u.pn * 128 + wc * 32 + 8 * fq;
        float rs[2][4]; row_scales(part, tab, pm0, u.pm, row0, wr, fr, fq, rs);
#pragma unroll
        for (int ai = 0; ai < 2; ++ai)
#pragma unroll
            for (int m = 0; m < 4; ++m) {
                const int row = row0 + ai * 128 + m * 16; const float s = rs[ai][m], sl = s * -1.4426950408889634f, s2 = s * s;
                const f32x4 g0 = acc[ai][0][m][0], g1 = acc[ai][0][m][1];
                const f32x4 a0 = g0 * sl, a1 = g1 * sl;
                const f32x4 e0 = (f32x4){__builtin_amdgcn_exp2f(a0[0]), __builtin_amdgcn_exp2f(a0[1]), __builtin_amdgcn_exp2f(a0[2]), __builtin_amdgcn_exp2f(a0[3])} + 1.0f;
                const f32x4 e1 = (f32x4){__builtin_amdgcn_exp2f(a1[0]), __builtin_amdgcn_exp2f(a1[1]), __builtin_amdgcn_exp2f(a1[2]), __builtin_amdgcn_exp2f(a1[3])} + 1.0f;
                const f32x4 r0 = (f32x4){__builtin_amdgcn_rcpf(e0[0]), __builtin_amdgcn_rcpf(e0[1]), __builtin_amdgcn_rcpf(e0[2]), __builtin_amdgcn_rcpf(e0[3])};
                const f32x4 r1 = (f32x4){__builtin_amdgcn_rcpf(e1[0]), __builtin_amdgcn_rcpf(e1[1]), __builtin_amdgcn_rcpf(e1[2]), __builtin_amdgcn_rcpf(e1[3])};
                *(u32x4*)(act + (unsigned)(row * FF + col0)) = pack8((g0 * acc[ai][1][m][0]) * s2 * r0, (g1 * acc[ai][1][m][1]) * s2 * r1);
            }
    }
};
__device__ __forceinline__ f32x4 unpk_lo(u32x4 w) { return (f32x4){bf_lo(w.x), bf_hi(w.x), bf_lo(w.y), bf_hi(w.y)}; }
__device__ __forceinline__ f32x4 unpk_hi(u32x4 w) { return (f32x4){bf_lo(w.z), bf_hi(w.z), bf_lo(w.w), bf_hi(w.w)}; }
struct EpiResid {
    bf16_t* hb; float* part; float scale;
    __device__ __forceinline__ void operator()(const AccT& acc, const Unit& u, int wr, int wc, int fr, int fq) const {
        const int row0 = u.pm * 256 + wr * 64 + fr, col0 = u.pn * 256 + wc * 32 + 8 * fq;
        u32x4 hv[2][4][2];
#pragma unroll
        for (int ai = 0; ai < 2; ++ai)
#pragma unroll
            for (int m = 0; m < 4; ++m)
#pragma unroll
                for (int bj = 0; bj < 2; ++bj) hv[ai][m][bj] = *(const u32x4*)(hb + (unsigned)((row0 + ai * 128 + m * 16) * DM + col0 + bj * 128));
#pragma unroll
        for (int ai = 0; ai < 2; ++ai) {
#pragma unroll
            for (int m = 0; m < 4; ++m) {
                const int row = row0 + ai * 128 + m * 16; float ss = 0.f;
#pragma unroll
                for (int bj = 0; bj < 2; ++bj) {
                    const unsigned o = (unsigned)(row * DM + col0 + bj * 128);
                    const f32x4 h0 = unpk_lo(hv[ai][m][bj]) + acc[ai][bj][m][0] * scale, h1 = unpk_hi(hv[ai][m][bj]) + acc[ai][bj][m][1] * scale;
                    *(u32x4*)(hb + o) = pack8(h0, h1);
                    ss += sumsq8(h0, h1);
                }
                ss += __shfl_xor(ss, 16); ss += __shfl_xor(ss, 32);
                if (fq == 0) part[(unsigned)(row * 32 + 4 * u.pn + wc)] = ss;
            }
        }
    }
};
struct EpiMixIn {
    bf16_t* mx; float* zb; const float* part; const LAS float* tab; int pm0;
    __device__ __forceinline__ void operator()(const AccT& acc, const Unit& u, int wr, int wc, int fr, int fq) const {
        const int row0 = u.pm * 256 + wr * 64 + fr, pn = u.pn, col0 = pn * 256 + wc * 32 + 8 * fq;
        float rs[2][4]; row_scales(part, tab, pm0, u.pm, row0, wr, fr, fq, rs);
#pragma unroll
        for (int ai = 0; ai < 2; ++ai)
#pragma unroll
            for (int m = 0; m < 4; ++m) {
                const int row = row0 + ai * 128 + m * 16; const float s = rs[ai][m];
#pragma unroll
                for (int bj = 0; bj < 2; ++bj) {
                    f32x4 v0 = acc[ai][bj][m][0] * s, v1 = acc[ai][bj][m][1] * s;
                    if (pn < 8) { v0 = gelu4(v0); v1 = gelu4(v1); }
                    else if (pn < 10) { v0 = v0 * 0.08838834764831845f; v1 = v1 * 0.08838834764831845f; }
                    else if (pn >= 16 && pn < 20) { v0 = silu4(v0); v1 = silu4(v1); }
                    if (pn < 20) *(u32x4*)(mx + (unsigned)(row * MXW + col0 + bj * 128)) = pack8(v0, v1);
                    else if (bj == 0 && wc == 0 && fq < 2) { float* z = zb + (unsigned)(row * 16 + 8 * fq); *(f32x4*)z = v0; *(f32x4*)(z + 4) = v1; }
                }
            }
    }
};
struct EpiStore {
    bf16_t* o;
    __device__ __forceinline__ void operator()(const AccT& acc, const Unit& u, int wr, int wc, int fr, int fq) const {
        const int row0 = u.pm * 256 + wr * 64 + fr, col0 = u.pn * 256 + wc * 32 + 8 * fq;
#pragma unroll
        for (int ai = 0; ai < 2; ++ai)
#pragma unroll
            for (int m = 0; m < 4; ++m)
                {
#pragma unroll
                  for (int bj = 0; bj < 2; ++bj)
                    *(u32x4*)(o + (unsigned)((row0 + ai * 128 + m * 16) * DM + col0 + bj * 128)) = pack8(acc[ai][bj][m][0], acc[ai][bj][m][1]);
                  asm volatile("" ::: "memory"); }
    }
};
struct EpiPle {
    const bf16_t* hsrc; bf16_t* hdst; const bf16_t* pp; const float* part_in; float* part_out; const LAS float* tab; int pm0;
    __device__ __forceinline__ void operator()(const AccT& acc, const Unit& u, int wr, int wc, int fr, int fq) const {
        const int row0 = u.pm * 256 + wr * 64 + fr, col0 = u.pn * 256 + wc * 32 + 8 * fq;
        float rs[2][4]; row_scales(part_in, tab, pm0, u.pm, row0, wr, fr, fq, rs);
        u32x4 hv[2][2][2], pw[2][2][2];
#define PLE_LOAD(buf, b) do { _Pragma("unroll") for (int mm = 0; mm < 2; ++mm) _Pragma("unroll") for (int bj = 0; bj < 2; ++bj) { \
            const unsigned o_ = (unsigned)((row0 + ((b) >> 1) * 128 + (2 * ((b) & 1) + mm) * 16) * DM + col0 + bj * 128); hv[buf][mm][bj] = *(const u32x4*)(hsrc + o_); pw[buf][mm][bj] = *(const u32x4*)(pp + o_); } } while (0)
        PLE_LOAD(0, 0);
#pragma unroll
        for (int b = 0; b < 4; ++b) {
            const int ai = b >> 1, mp = b & 1, cur = b & 1;
            if (b < 3) { if (cur == 0) PLE_LOAD(1, b + 1); else PLE_LOAD(0, b + 1); }
#pragma unroll
            for (int mm = 0; mm < 2; ++mm) {
                const int m = 2 * mp + mm, row = row0 + ai * 128 + m * 16; const float s = rs[ai][m]; float ss = 0.f;
#pragma unroll
                for (int bj = 0; bj < 2; ++bj) {
                    const unsigned o = (unsigned)(row * DM + col0 + bj * 128);
                    const f32x4 h0 = unpk_lo(hv[cur][mm][bj]) + sigm4(acc[ai][bj][m][0] * s) * unpk_lo(pw[cur][mm][bj]), h1 = unpk_hi(hv[cur][mm][bj]) + sigm4(acc[ai][bj][m][1] * s) * unpk_hi(pw[cur][mm][bj]);
                    *(u32x4*)(hdst + o) = pack8(h0, h1);
                    ss += sumsq8(h0, h1);
                }
                ss += __shfl_xor(ss, 16); ss += __shfl_xor(ss, 32);
                if (fq == 0) part_out[(unsigned)(row * 32 + 4 * u.pn + wc)] = ss;
            }
        }
#undef PLE_LOAD
    }
};

template <int MODE>
__device__ __forceinline__ void conv_item(const float* __restrict__ W, const float* __restrict__ gain, int K, int N, bf16_t* __restrict__ WT, int kb, int nb, LAS float* scr, int lane) {
    const int k0 = kb * 64, n0 = nb * 64, cc = lane & 15, kr = lane >> 4;
    f32x4 v[16];
#pragma unroll
    for (int i = 0; i < 16; ++i) { const int kk = 4 * i + kr, n = n0 + 4 * cc;
        v[i] = (n < N) ? __builtin_nontemporal_load((const f32x4*)(W + (size_t)(k0 + kk) * N + n)) : (f32x4){0.f, 0.f, 0.f, 0.f}; }
#pragma unroll
    for (int i = 0; i < 16; ++i) { const int kk = 4 * i + kr; const float g = gain ? gain[k0 + kk] : 1.0f;
        LAS float* d = scr + kk * 65 + 4 * cc; d[0] = v[i][0] * g; d[1] = v[i][1] * g; d[2] = v[i][2] * g; d[3] = v[i][3] * g; }
    LDS_WAIT();
    const int c = lane & 7, nl = lane >> 3;
#pragma unroll
    for (int j = 0; j < 8; ++j) { const int n = nl + 8 * j; const LAS float* s = scr + (8 * c) * 65 + n;
        u32x4 o; o.x = cvt_pk_bf16(s[0], s[65]); o.y = cvt_pk_bf16(s[130], s[195]); o.z = cvt_pk_bf16(s[260], s[325]); o.w = cvt_pk_bf16(s[390], s[455]);
        const int ng = n0 + n; int row = ng;
        if (MODE == 1) { row = (ng < FF) ? (256 * (ng >> 7) + (ng & 127)) : (256 * ((ng - FF) >> 7) + 128 + ((ng - FF) & 127)); }
        *(u32x4*)(WT + (size_t)row * K + k0 + 8 * c) = o; }
    LDS_WAIT();
}


#define XB_TMO      128
#define XB_XCNT(j)  (256  + 64 * (j))
#define XB_XSUB(j)  (1280 + 64 * (j))
#define XB_XGEN(j)  (2304 + 64 * (j))
#define XB_TOP      3328
#define XB_TOPGEN   3392
#define XCD_BAR_WORDS 3456
#define XB_SPIN_CAP (1u << 22)
__device__ __forceinline__ unsigned xb_ld(unsigned* p)              { return __hip_atomic_load(p, __ATOMIC_RELAXED, __HIP_MEMORY_SCOPE_AGENT); }
__device__ __forceinline__ unsigned xb_add(unsigned* p, unsigned v) { return __hip_atomic_fetch_add(p, v, __ATOMIC_RELAXED, __HIP_MEMORY_SCOPE_AGENT); }
__device__ __forceinline__ unsigned xb_xcc_id() { return (unsigned)__builtin_amdgcn_s_getreg((3 << 11) | 20) & 0xFu; }
#define XB_SPIN(cond, bar) do { unsigned _sp = 0; while (cond) { __builtin_amdgcn_s_sleep(1); \
    if ((++_sp & 255u) == 0u) { if (xb_ld(&(bar)[XB_TMO])) break; if (_sp > XB_SPIN_CAP) { atomicAdd(&(bar)[XB_TMO], 1u); break; } } } } while (0)
__device__ __forceinline__ void xcd_barrier_complete(unsigned* bar, unsigned x, unsigned& nloc, unsigned& nx) {
    const unsigned G = gridDim.x;
    unsigned sum, cnt, mine, sp = 0u;
    for (;;) {
        sum = 0u; cnt = 0u; mine = 0u;
#pragma unroll
        for (unsigned j = 0; j < 16; ++j) { const unsigned c = xb_ld(&bar[XB_XCNT(j)]); sum += c; cnt += (c > 0u) ? 1u : 0u; mine = (j == x) ? c : mine; }
        if (sum == G) break;
        __builtin_amdgcn_s_sleep(1);
        if ((++sp & 255u) == 0u) { if (xb_ld(&bar[XB_TMO])) break; if (sp > XB_SPIN_CAP) { atomicAdd(&bar[XB_TMO], 1u); break; } }
    }
    nloc = mine > 0u ? mine : 1u; nx = cnt > 0u ? cnt : 1u;
}
__device__ __forceinline__ void xcd_barrier(unsigned* bar, volatile LAS unsigned* st) {
    asm volatile("s_waitcnt vmcnt(0)" ::: "memory");
    __syncthreads();
    if (threadIdx.x == 0) {
        const unsigned x = xb_xcc_id();
        __builtin_amdgcn_s_waitcnt(0);
        unsigned nloc = st[0], nx = st[1];
        if (nloc == 0u) { xcd_barrier_complete(bar, x, nloc, nx); st[0] = nloc; st[1] = nx; }
        const unsigned old = xb_add(&bar[XB_XSUB(x)], 1u);
        const unsigned gen = old / nloc;
        if (old + 1u == (gen + 1u) * nloc) {
            __builtin_amdgcn_fence(__ATOMIC_RELEASE, "agent");
            asm volatile("s_waitcnt vmcnt(0)" ::: "memory");
            const unsigned og = xb_add(&bar[XB_TOP], 1u);
            const unsigned tg = og / nx;
            if (og + 1u == (tg + 1u) * nx) xb_add(&bar[XB_TOPGEN], 1u);
            else XB_SPIN(xb_ld(&bar[XB_TOPGEN]) == tg, bar);
            __builtin_amdgcn_fence(__ATOMIC_ACQUIRE, "agent");
            asm volatile("s_waitcnt vmcnt(0)" ::: "memory");
        } else {
            XB_SPIN(xb_ld(&bar[XB_TOPGEN]) == gen, bar);
            __builtin_amdgcn_fence(__ATOMIC_ACQUIRE, "agent");
            asm volatile("s_waitcnt vmcnt(0)" ::: "memory");
        }
    }
    __syncthreads();
}

__device__ __forceinline__ unsigned xcd_barrier_arrive(unsigned* bar, volatile LAS unsigned* st) {
    unsigned gen = 0u;
    asm volatile("s_waitcnt vmcnt(0)" ::: "memory");
    __syncthreads();
    if (threadIdx.x == 0) {
        const unsigned x = xb_xcc_id();
        __builtin_amdgcn_s_waitcnt(0);
        unsigned nloc = st[0], nx = st[1];
        if (nloc == 0u) { xcd_barrier_complete(bar, x, nloc, nx); st[0] = nloc; st[1] = nx; }
        const unsigned old = xb_add(&bar[XB_XSUB(x)], 1u);
        gen = old / nloc;
        if (old + 1u == (gen + 1u) * nloc) {
            __builtin_amdgcn_fence(__ATOMIC_RELEASE, "agent");
            asm volatile("s_waitcnt vmcnt(0)" ::: "memory");
            const unsigned og = xb_add(&bar[XB_TOP], 1u);
            const unsigned tg = og / nx;
            if (og + 1u == (tg + 1u) * nx) xb_add(&bar[XB_TOPGEN], 1u);
        }
    }
    return gen;
}
__device__ __forceinline__ void xcd_barrier_wait(unsigned* bar, unsigned gen) {
    if (threadIdx.x == 0) {
        XB_SPIN(xb_ld(&bar[XB_TOPGEN]) == gen, bar);
        __builtin_amdgcn_fence(__ATOMIC_ACQUIRE, "agent");
        asm volatile("s_waitcnt vmcnt(0)" ::: "memory");
    }
    __syncthreads();
}

struct Args { const float* in[21]; float* out; unsigned char* ws; };
typedef const __attribute__((address_space(4))) char* kptr_t;
__device__ __forceinline__ const float* in_ptr(int i) { int off = i * 8; asm volatile("" : "+s"(off)); kptr_t kp = (kptr_t)__builtin_amdgcn_kernarg_segment_ptr(); return *(const float* const __attribute__((address_space(4)))*)(kp + off); }
__device__ __forceinline__ float* out_ptr() { return (float*)in_ptr(21); }
__device__ __forceinline__ unsigned char* ws_ptr() { return (unsigned char*)in_ptr(22); }
enum { I_X = 0, I_P, I_F1N, I_F1I, I_F1O, I_MXN, I_MXI, I_SGVG, I_SGW, I_SGB, I_GWG, I_GBG, I_GOG, I_MXO, I_F2N, I_F2I, I_F2O, I_PLN, I_PLG, I_PLP, I_FIN };

constexpr int I_1I = (DM / 64) * (NIN / 64), I_1O = (FF / 64) * (DM / 64), I_MI = (DM / 64) * (NMIXP / 64), I_MO = (DM / 64) * (DM / 64), I_PP = (DPLE / 64) * (DM / 64);
constexpr int PER_LAYER = 2 * I_1I + 2 * I_1O + I_MI + 2 * I_MO + I_PP;
constexpr int CV_PRO = I_1I;
constexpr int CV_E0 = CV_PRO + 8000;
constexpr int CV_E2 = CV_E0 + 5120;
constexpr int CV_E7 = PER_LAYER + I_1I;
constexpr int CV_E10 = CV_E7 + 8000, CV_E12 = CV_E10 + 5120, CV_E17 = 2 * PER_LAYER;
static_assert(CV_E0 >= CV_PRO + I_1O + I_MI && CV_E2 >= CV_PRO + I_1O + I_MI + I_PP + I_MO + I_1I && CV_E2 <= CV_E7 && CV_E10 >= CV_E7 + I_1O + I_MI && CV_E12 >= CV_E7 + I_1O + I_MI + I_PP + I_MO + I_1I && CV_E12 <= CV_E17, "every weight range is converted at least one barrier before its first use");
__device__ __forceinline__ void convert_items(LAS unsigned char* lds, int it0, int it1, int worker, int nworkers) {
    const int tid = opaque_tid(), lane = tid & 63, wave = __builtin_amdgcn_readfirstlane(tid >> 6);
    LAS float* scr = (LAS float*)(lds + wave * 16640);
    unsigned char* ws = ws_ptr();
    for (int it = it0 + worker * 8 + wave; it < it1; it += nworkers * 8) {
        const int l = (it >= PER_LAYER) ? 1 : 0; int r = it - l * PER_LAYER;
        unsigned char* wl = ws + (size_t)l * SZ_LAYER;
#define CONV(MODE, src, gain, K, N, NPAD, dstoff) { constexpr int nbk = (NPAD) / 64, cnt = ((K) / 64) * nbk; \
        if (r < cnt) { conv_item<MODE>((src) + (size_t)l * (K) * (N), (gain), (K), (N), (bf16_t*)(wl + (dstoff)), r / nbk, r % nbk, scr, lane); continue; } r -= cnt; }
        CONV(1, in_ptr(I_F1I), in_ptr(I_F1N) + l * DM, DM, NIN, NIN, OFF_W1I)
        CONV(0, in_ptr(I_F1O), (const float*)nullptr, FF, DM, DM, OFF_W1O)
        CONV(0, in_ptr(I_MXI), in_ptr(I_MXN) + l * DM, DM, NMIX, NMIXP, OFF_WMI)
        CONV(0, in_ptr(I_PLP), (const float*)nullptr, DPLE, DM, DM, OFF_WPP)
        CONV(0, in_ptr(I_MXO), (const float*)nullptr, DM, DM, DM, OFF_WMO)
        CONV(1, in_ptr(I_F2I), in_ptr(I_F2N) + l * DM, DM, NIN, NIN, OFF_W2I)
        CONV(0, in_ptr(I_F2O), (const float*)nullptr, FF, DM, DM, OFF_W2O)
        CONV(0, in_ptr(I_PLG), in_ptr(I_PLN) + l * DM, DM, DM, DM, OFF_WPG)
#undef CONV
    }
}
__device__ __forceinline__ void prologue(LAS unsigned char* lds, int G) {
    const int tid = opaque_tid(), lane = tid & 63, wave = __builtin_amdgcn_readfirstlane(tid >> 6);
    const int gw = blockIdx.x * 8 + wave, NGW = G * 8;
    unsigned char* ws = ws_ptr();
    bf16_t* HB = (bf16_t*)(ws + WS_HB); float* PA = (float*)(ws + WS_PARTA);
    for (int m = 2 * gw; m < MTOK; m += 2 * NGW) {
        f32x4 v[2][8]; float sq[2];
#pragma unroll
        for (int r = 0; r < 2; ++r) { const f32x4* xr = (const f32x4*)(in_ptr(I_X) + (size_t)(m + r) * DM) + lane;
#pragma unroll
            for (int j = 0; j < 8; ++j) v[r][j] = xr[64 * j]; }
#pragma unroll
        for (int r = 0; r < 2; ++r) { float t = 0.f;
#pragma unroll
            for (int j = 0; j < 8; ++j) t += (v[r][j][0] * v[r][j][0] + v[r][j][1] * v[r][j][1]) + (v[r][j][2] * v[r][j][2] + v[r][j][3] * v[r][j][3]);
            sq[r] = wave_sum(t); }
#pragma unroll
        for (int r = 0; r < 2; ++r) { u32x2* o8 = (u32x2*)(HB + (size_t)(m + r) * DM) + lane;
#pragma unroll
            for (int j = 0; j < 8; ++j) { u32x2 w; w.x = cvt_pk_bf16(v[r][j][0], v[r][j][1]); w.y = cvt_pk_bf16(v[r][j][2], v[r][j][3]); o8[64 * j] = w; }
            if (lane < 32) PA[(size_t)(m + r) * 32 + lane] = (lane == 0) ? sq[r] : 0.f; }
    }
}
__device__ __forceinline__ void prologue_p(int G) {
    const int tid = opaque_tid(), lane = tid & 63, wave = __builtin_amdgcn_readfirstlane(tid >> 6);
    const int gw = blockIdx.x * 8 + wave, NGW = G * 8;
    unsigned char* ws = ws_ptr();
    bf16_t* PB = (bf16_t*)(ws + WS_PB);
    for (int m = 4 * gw; m < 2 * MTOK; m += 4 * NGW) {
        f32x4 v[4];
#pragma unroll
        for (int r = 0; r < 4; ++r) v[r] = *((const f32x4*)(in_ptr(I_P) + (size_t)(m + r) * DPLE) + lane);
#pragma unroll
        for (int r = 0; r < 4; ++r) { u32x2 w; w.x = cvt_pk_bf16(v[r][0], v[r][1]); w.y = cvt_pk_bf16(v[r][2], v[r][3]); *((u32x2*)(PB + (size_t)(m + r) * DPLE) + lane) = w; }
    }
}

#define MFMA16(X, Y, C) __builtin_amdgcn_mfma_f32_16x16x32_bf16((X), (Y), (C), 0, 0, 0)
__device__ __forceinline__ void sg_unit(LAS unsigned char* lds, int unit, int l) {
    const int tid = opaque_tid(), lane = tid & 63, w = __builtin_amdgcn_readfirstlane(tid >> 6), fr = lane & 15, fq = lane >> 4;
    const int h = unit & 7, t0 = (unit >> 3) * 128;
    LAS bf16_t* Vt = (LAS bf16_t*)lds;
    LAS bf16_t* Wl = (LAS bf16_t*)(lds + 34816);
    LAS float* red = (LAS float*)(lds + 69632);
    const bf16_t* MX = (const bf16_t*)(ws_ptr() + WS_MX); bf16_t* YM = (bf16_t*)(ws_ptr() + WS_YM);
    const int s = tid & 127, part = tid >> 7;
    float x[32];
    {
        const u32x4* src = (const u32x4*)(MX + (size_t)(t0 + s) * MXW + 1024 + h * 128 + 32 * part);
        float sum = 0.f, sq = 0.f;
#pragma unroll
        for (int j = 0; j < 4; ++j) { const u32x4 q = src[j];
            x[8 * j + 0] = bf_lo(q.x); x[8 * j + 1] = bf_hi(q.x); x[8 * j + 2] = bf_lo(q.y); x[8 * j + 3] = bf_hi(q.y);
            x[8 * j + 4] = bf_lo(q.z); x[8 * j + 5] = bf_hi(q.z); x[8 * j + 6] = bf_lo(q.w); x[8 * j + 7] = bf_hi(q.w); }
#pragma unroll
        for (int e = 0; e < 32; ++e) { sum += x[e]; sq += x[e] * x[e]; }
        red[part * 128 + s] = sum; red[512 + part * 128 + s] = sq;
    }
    {
        const float* wsrc = in_ptr(I_SGW) + (size_t)(l * 8 + h) * 128 * 128;
#pragma unroll
        for (int j = 0; j < 8; ++j) { const int idx = tid + 512 * j, t = idx >> 5, c4 = idx & 31;
            f32x4 wv = *(const f32x4*)(wsrc + t * 128 + 4 * c4);
#pragma unroll
            for (int e = 0; e < 4; ++e) if (4 * c4 + e > t) wv[e] = 0.f;
            u32x2 o; o.x = cvt_pk_bf16(wv[0], wv[1]); o.y = cvt_pk_bf16(wv[2], wv[3]);
            *(LAS u32x2*)(Wl + t * 136 + 4 * c4) = o; }
    }
    __syncthreads();
    {
        const float sum = (red[s] + red[128 + s]) + (red[256 + s] + red[384 + s]), sq = (red[512 + s] + red[640 + s]) + (red[768 + s] + red[896 + s]);
        const float mean = sum * (1.0f / 128.0f), var = fmaxf(sq * (1.0f / 128.0f) - mean * mean, 0.f), rstd = rsqrtf(var + EPS);
        const float* gv = in_ptr(I_SGVG) + l * 1024 + h * 128 + 32 * part;
#pragma unroll
        for (int e = 0; e < 32; ++e) Vt[(32 * part + e) * 136 + s] = f2bf((x[e] - mean) * rstd * gv[e]);
    }
    __syncthreads();
    const int tq = 16 * w + fr; const float bias = in_ptr(I_SGB)[(l * 8 + h) * 128 + tq];
    const bf16_t* urow = MX + (size_t)(t0 + tq) * MXW + h * 128 + 4 * fq;
    u32x2 uuv[8];
#pragma unroll
    for (int nt = 0; nt < 8; ++nt) uuv[nt] = *(const u32x2*)(urow + 16 * nt);
    f32x4 acc[8];
#pragma unroll
    for (int nt = 0; nt < 8; ++nt) acc[nt] = (f32x4){0.f, 0.f, 0.f, 0.f};
    const int nks = (w >> 1) + 1;
    for (int ks = 0; ks < nks; ++ks) {
        const bf16x8 A = *(const LAS bf16x8*)(Wl + (16 * w + fr) * 136 + 32 * ks + 8 * fq);
#pragma unroll
        for (int nt = 0; nt < 8; ++nt) { const bf16x8 B = *(const LAS bf16x8*)(Vt + (16 * nt + fr) * 136 + 32 * ks + 8 * fq); acc[nt] = MFMA16(B, A, acc[nt]); }
    }
    {
        bf16_t* yrow = YM + (size_t)(t0 + tq) * DM + h * 128 + 4 * fq;
#pragma unroll
        for (int nt = 0; nt < 8; ++nt) { const u32x2 uu = uuv[nt];
            u32x2 o; o.x = cvt_pk_bf16(bf_lo(uu.x) * (acc[nt][0] + bias), bf_hi(uu.x) * (acc[nt][1] + bias)); o.y = cvt_pk_bf16(bf_lo(uu.y) * (acc[nt][2] + bias), bf_hi(uu.y) * (acc[nt][3] + bias));
            *(u32x2*)(yrow + 16 * nt) = o; }
    }
    __syncthreads();
}

constexpr int GL_QS = 0, GL_KS = 17408, GL_VT = 34816, GL_PS = 71680, GL_KD = 80896, GL_ZS = 99328, GL_TOT = 103424, GL_SS = 105472;
constexpr int GC = 128, NCH = SEQ / GC;
constexpr int GA_VT = 0, GA_KD = 69632, GA_ZS = 104448, GA_TOT = 112640;
constexpr int GCc_VT = 0, GCc_PS = 69632;
__device__ __forceinline__ void gla_a_unit(LAS unsigned char* lds, int unit, int l) {
    const int tid = opaque_tid(), lane = tid & 63, w = __builtin_amdgcn_readfirstlane(tid >> 6), fr = lane & 15, fq = lane >> 4;
    const int bh = unit / NCH, c = unit - bh * NCH, b = bh >> 2, h = bh & 3, t0 = b * SEQ + GC * c;
    LAS bf16_t* Vt = (LAS bf16_t*)(lds + GA_VT); LAS bf16_t* KDt = (LAS bf16_t*)(lds + GA_KD);
    LAS float* Zs = (LAS float*)(lds + GA_ZS); LAS float* TOT = (LAS float*)(lds + GA_TOT);
    const bf16_t* MX = (const bf16_t*)(ws_ptr() + WS_MX); const float* ZB = (const float*)(ws_ptr() + WS_ZB);
    *(LAS f32x4*)(Zs + tid * 4) = *(const f32x4*)(ZB + (size_t)t0 * 16 + tid * 4);
#pragma unroll
    for (int p = 0; p < 2; ++p) {
        const u32x4* src = (const u32x4*)(MX + (size_t)(t0 + 64 * p + lane) * MXW + 3072 + h * 256 + 32 * w);
#pragma unroll
        for (int j = 0; j < 4; ++j) { const u32x4 q = src[j]; LAS bf16_t* d = Vt + (32 * w + 8 * j) * 136 + 64 * p + lane;
            d[0] = (bf16_t)(q.x & 0xffff); d[136] = (bf16_t)(q.x >> 16); d[272] = (bf16_t)(q.y & 0xffff); d[408] = (bf16_t)(q.y >> 16);
            d[544] = (bf16_t)(q.z & 0xffff); d[680] = (bf16_t)(q.z >> 16); d[816] = (bf16_t)(q.w & 0xffff); d[952] = (bf16_t)(q.w >> 16); }
    }
    const int kk = tid & 127, tg = tid >> 7;
    bf16_t qraw[32], kraw[32];
    { const bf16_t* qsrc0 = MX + (size_t)(t0 + 32 * tg) * MXW + 2048 + h * 128 + kk;
#pragma unroll
      for (int i = 0; i < 32; ++i) { kraw[i] = qsrc0[(size_t)i * MXW + 512]; qraw[i] = qsrc0[(size_t)i * MXW]; } }
    float wg[16];
#pragma unroll
    for (int r = 0; r < 16; ++r) wg[r] = in_ptr(I_GWG)[(size_t)(l * 16 + r) * 512 + h * 128 + kk];
    const float bg = in_ptr(I_GBG)[l * 512 + h * 128 + kk];
    __syncthreads();
    float bl[32]; float cum = 0.f;
#pragma unroll
    for (int i = 0; i < 32; ++i) { const LAS float* z = Zs + (32 * tg + i) * 16; float g = bg;
#pragma unroll
        for (int r = 0; r < 16; ++r) g += z[r] * wg[r];
        const float ls = fminf(g, 0.f) - __logf(1.0f + __expf(-fabsf(g)));
        cum += ls * (1.0f / 16.0f); bl[i] = cum; }
    TOT[tg * 128 + kk] = cum;
    __syncthreads();
    float off = 0.f, blast = 0.f;
#pragma unroll
    for (int g = 0; g < 4; ++g) { const float t = TOT[g * 128 + kk]; blast += t; if (g < tg) off += t; }
    bf16_t* qt = (bf16_t*)(ws_ptr() + WS_QT) + (size_t)(t0 + 32 * tg) * 1024 + h * 256 + kk;
#pragma unroll
    for (int i8 = 0; i8 < 4; ++i8) {
        float kd[8];
#pragma unroll
        for (int e = 0; e < 8; ++e) { const int i = 8 * i8 + e; const float bb = bl[i] + off, kv = bf_one(kraw[i]);
            kd[e] = kv * __expf(blast - bb);
            qt[(size_t)i * 1024] = f2bf(bf_one(qraw[i]) * __expf(bb)); qt[(size_t)i * 1024 + 128] = f2bf(kv * __expf(-bb)); }
        u32x4 o; o.x = cvt_pk_bf16(kd[0], kd[1]); o.y = cvt_pk_bf16(kd[2], kd[3]); o.z = cvt_pk_bf16(kd[4], kd[5]); o.w = cvt_pk_bf16(kd[6], kd[7]);
        *(LAS u32x4*)(KDt + kk * 136 + 32 * tg + 8 * i8) = o;
    }
    if (tg == 0) ((float*)(ws_ptr() + WS_DEC))[(size_t)(bh * NCH + c) * 128 + kk] = __expf(blast);
    __syncthreads();
    f32x4 acc[2][8];
#pragma unroll
    for (int mi = 0; mi < 2; ++mi)
#pragma unroll
        for (int nt = 0; nt < 8; ++nt) acc[mi][nt] = (f32x4){0.f, 0.f, 0.f, 0.f};
#pragma unroll
    for (int ks = 0; ks < 4; ++ks) {
        const bf16x8 A0 = *(const LAS bf16x8*)(Vt + (32 * w + fr) * 136 + 32 * ks + 8 * fq), A1 = *(const LAS bf16x8*)(Vt + (32 * w + 16 + fr) * 136 + 32 * ks + 8 * fq);
#pragma unroll
        for (int nt = 0; nt < 8; ++nt) { const bf16x8 B = *(const LAS bf16x8*)(KDt + (16 * nt + fr) * 136 + 32 * ks + 8 * fq);
            acc[0][nt] = MFMA16(B, A0, acc[0][nt]); acc[1][nt] = MFMA16(B, A1, acc[1][nt]); }
    }
    float* UT = (float*)(ws_ptr() + WS_ACT) + (size_t)(bh * NCH + c) * 256 * 128;
#pragma unroll
    for (int mi = 0; mi < 2; ++mi)
#pragma unroll
        for (int nt = 0; nt < 8; ++nt) *(f32x4*)(UT + (size_t)(32 * w + 16 * mi + fr) * 128 + 16 * nt + 4 * fq) = acc[mi][nt];
    __syncthreads();
}
__device__ __forceinline__ void gla_c_unit(LAS unsigned char* lds, int unit, int l) {
    const int tid = opaque_tid(), lane = tid & 63, w = __builtin_amdgcn_readfirstlane(tid >> 6), fr = lane & 15, fq = lane >> 4;
    const int bh = unit / NCH, c = unit - bh * NCH, b = bh >> 2, h = bh & 3, t0 = b * SEQ + GC * c;
    LAS bf16_t* Vt = (LAS bf16_t*)(lds + GCc_VT); LAS bf16_t* Ps = (LAS bf16_t*)(lds + GCc_PS);
    const bf16_t* MX = (const bf16_t*)(ws_ptr() + WS_MX);
    const int i = 16 * w + fr;
    const bf16_t* QT = (const bf16_t*)(ws_ptr() + WS_QT) + (size_t)t0 * 1024 + h * 256;
    bf16x8 Aq[4];
#pragma unroll
    for (int ks = 0; ks < 4; ++ks) Aq[ks] = *(const bf16x8*)(QT + (size_t)i * 1024 + 32 * ks + 8 * fq);
#pragma unroll
    for (int p = 0; p < 2; ++p) {
        const u32x4* src = (const u32x4*)(MX + (size_t)(t0 + 64 * p + lane) * MXW + 3072 + h * 256 + 32 * w);
#pragma unroll
        for (int j = 0; j < 4; ++j) { const u32x4 q = src[j]; LAS bf16_t* d = Vt + (32 * w + 8 * j) * 136 + 64 * p + lane;
            d[0] = (bf16_t)(q.x & 0xffff); d[136] = (bf16_t)(q.x >> 16); d[272] = (bf16_t)(q.y & 0xffff); d[408] = (bf16_t)(q.y >> 16);
            d[544] = (bf16_t)(q.z & 0xffff); d[680] = (bf16_t)(q.z >> 16); d[816] = (bf16_t)(q.w & 0xffff); d[952] = (bf16_t)(q.w >> 16); }
    }
#pragma unroll
    for (int nt = 0; nt < 8; ++nt) {
        f32x4 p = (f32x4){0.f, 0.f, 0.f, 0.f};
        if (nt <= w) {
#pragma unroll
            for (int ks = 0; ks < 4; ++ks) { const bf16x8 B = *(const bf16x8*)(QT + (size_t)(16 * nt + fr) * 1024 + 128 + 32 * ks + 8 * fq); p = MFMA16(B, Aq[ks], p); }
        }
        const int j0 = 16 * nt + 4 * fq;
#pragma unroll
        for (int jj = 0; jj < 4; ++jj) if (j0 + jj > i) p[jj] = 0.f;
        u32x2 o; o.x = cvt_pk_bf16(p[0], p[1]); o.y = cvt_pk_bf16(p[2], p[3]);
        *(LAS u32x2*)(Ps + i * 136 + j0) = o;
    }
    f32x4 acc[16];
#pragma unroll
    for (int nt = 0; nt < 16; ++nt) acc[nt] = (f32x4){0.f, 0.f, 0.f, 0.f};
    const bf16_t* ST = (const bf16_t*)(ws_ptr() + WS_ST) + (size_t)(bh * NCH + c) * 256 * 128;
#pragma unroll
    for (int nt = 0; nt < 16; ++nt) { const bf16_t* srow = ST + (size_t)(16 * nt + fr) * 128 + 8 * fq;
#pragma unroll
        for (int ks = 0; ks < 4; ++ks) { const bf16x8 B = *(const bf16x8*)(srow + 32 * ks); acc[nt] = MFMA16(B, Aq[ks], acc[nt]); } }
    const float* og = in_ptr(I_GOG) + l * 1024 + h * 256 + 4 * fq;
    const bf16_t* rrow = MX + (size_t)(t0 + i) * MXW + 4096 + h * 256 + 4 * fq;
    f32x4 g4v[16]; u32x2 rrv[16];
#pragma unroll
    for (int nt = 0; nt < 16; ++nt) { g4v[nt] = *(const f32x4*)(og + 16 * nt); rrv[nt] = *(const u32x2*)(rrow + 16 * nt); }
    __syncthreads();
    const int nks = (w >> 1) + 1;
#pragma unroll
    for (int ks = 0; ks < 4; ++ks) if (ks < nks) { const bf16x8 A = *(const LAS bf16x8*)(Ps + i * 136 + 32 * ks + 8 * fq);
#pragma unroll
        for (int nt = 0; nt < 16; ++nt) { const bf16x8 B = *(const LAS bf16x8*)(Vt + (16 * nt + fr) * 136 + 32 * ks + 8 * fq); acc[nt] = MFMA16(B, A, acc[nt]); } }
    float ss = 0.f;
#pragma unroll
    for (int nt = 0; nt < 16; ++nt) ss += (acc[nt][0] * acc[nt][0] + acc[nt][1] * acc[nt][1]) + (acc[nt][2] * acc[nt][2] + acc[nt][3] * acc[nt][3]);
    ss += __shfl_xor(ss, 16); ss += __shfl_xor(ss, 32);
    const float rstd = rsqrtf(ss * (1.0f / 256.0f) + EPS);
    bf16_t* yrow = (bf16_t*)(ws_ptr() + WS_YM) + (size_t)(t0 + i) * DM + 1024 + h * 256 + 4 * fq;
#pragma unroll
    for (int nt = 0; nt < 16; ++nt) { const f32x4 g4 = g4v[nt]; const u32x2 rr = rrv[nt];
        u32x2 o; o.x = cvt_pk_bf16(acc[nt][0] * rstd * g4[0] * bf_lo(rr.x), acc[nt][1] * rstd * g4[1] * bf_hi(rr.x));
        o.y = cvt_pk_bf16(acc[nt][2] * rstd * g4[2] * bf_lo(rr.y), acc[nt][3] * rstd * g4[3] * bf_hi(rr.y));
        *(u32x2*)(yrow + 16 * nt) = o; }
    __syncthreads();
}

__device__ __forceinline__ void gla_scan(int G) {
    const float* UT = (const float*)(ws_ptr() + WS_ACT); const float* DEC = (const float*)(ws_ptr() + WS_DEC); bf16_t* ST = (bf16_t*)(ws_ptr() + WS_ST);
    for (int idx = blockIdx.x * NTHREADS + opaque_tid(); idx < 8 * 256 * 64; idx += G * NTHREADS) {
        const int e = idx * 2, kk = e & 127, dv = (e >> 7) & 255, bh = e >> 15;
        f32x2 S = (f32x2){0.f, 0.f};
        const size_t base = ((size_t)bh * NCH * 256 + dv) * 128 + kk;
#pragma unroll 8
        for (int c = 0; c < NCH; ++c) {
            const f32x2 u = *(const f32x2*)(UT + base + (size_t)c * 256 * 128);
            const f32x2 d = *(const f32x2*)(DEC + (size_t)(bh * NCH + c) * 128 + kk);
            *(unsigned*)(ST + base + (size_t)c * 256 * 128) = cvt_pk_bf16(S[0], S[1]);
            S = S * d + u;
        }
    }
}

__global__ void __launch_bounds__(NTHREADS, 2) fwd_megakernel(Args a) {
    extern __shared__ __attribute__((aligned(16))) unsigned char lds_raw[];
    LAS unsigned char* lds = (LAS unsigned char*)lds_raw;
    cg::grid_group grid = cg::this_grid();
    const int G = gridDim.x;
    volatile LAS unsigned* bst = (volatile LAS unsigned*)(lds + 134144);
    if (threadIdx.x < 2) bst[threadIdx.x] = 0u;
    __syncthreads();
    if (threadIdx.x == 0) (void)xb_add(&((unsigned*)(ws_ptr() + WS_BAR))[XB_XCNT(xb_xcc_id())], 1u);
#define GRID_BAR() xcd_barrier((unsigned*)(ws_ptr() + WS_BAR), bst)
#define WSB(off) ((bf16_t*)(ws_ptr() + (off)))
#define WSF(off) ((float*)(ws_ptr() + (off)))
    if (G == 0x7fffffff) grid.sync();
    const bool win = (G == 256);
    int probe_rep = PROBE_MIX;
    for (int st = -1; st < 20; ++st) {
        int c0 = 0, c1 = 0, cw = (int)blockIdx.x, cn = G;
        if (st < 0) { prologue(lds, G); c1 = win ? CV_PRO : 2 * PER_LAYER; }
        else {
        const int l = st / 10, k = st - 10 * l;
        if (win) {
            if (k == 0) { c0 = l ? CV_E7 : CV_PRO; c1 = l ? CV_E10 : CV_E0; cw -= 128; cn = 128; }
            else if (k == 2) { c0 = l ? CV_E10 : CV_E0; c1 = l ? CV_E12 : CV_E2; cw -= 160; cn = 96; }
            else if (k == 7) { c0 = l ? CV_E12 : CV_E2; c1 = l ? CV_E17 : CV_E7; cw -= 128; cn = 128; }
        }
        const size_t lo = (size_t)l * SZ_LAYER;
        const size_t hbo = (l & 1) ? WS_HB2 : WS_HB, hbn = (l & 1) ? WS_HB : WS_HB2;
        pg8::StaticOrder S;
        if (k == 0 || k == 7) {
            pg8::Gemm g{WSB(hbo), WSB(lo + (k == 0 ? OFF_W1I : OFF_W2I)), MTOK, NIN, DM}; S.init(MTOK, NIN, G, (int)blockIdx.x);
            pg8::Unit u0; const bool has0 = S.next(0, u0); LAS float* tab = (LAS float*)(lds + RSTD_OFF);
            EpiSwiglu E{WSB(WS_ACT), WSF(WS_PARTA), tab, has0 ? u0.pm : -1};
            pg8::gemm_phase(lds, g, S, E, TabPre{tab, WSF(WS_PARTA), u0.pm});
        } else if (k == 1 || k == 6 || k == 8) {
            pg8::Gemm g{(k == 6) ? WSB(WS_YM) : WSB(WS_ACT), WSB(lo + (k == 1 ? OFF_W1O : (k == 6 ? OFF_WMO : OFF_W2O))), MTOK, DM, (k == 6) ? DM : FF}; S.init(MTOK, DM, G, (int)blockIdx.x);
            EpiResid E{WSB(hbo), (k == 6) ? WSF(WS_PARTA) : WSF(WS_PARTB), (k == 6) ? 1.0f : 0.5f};
            pg8::gemm_phase(lds, g, S, E, pg8::NoPre{});
        } else if (k == 2) {
            { pg8::Gemm g{WSB(hbo), WSB(lo + OFF_WMI), MTOK, NMIXP, DM}; S.init(MTOK, NMIXP, G, (int)blockIdx.x);
              pg8::Unit u0; const bool has0 = S.next(0, u0); LAS float* tab = (LAS float*)(lds + RSTD_OFF);
              EpiMixIn E{WSB(WS_MX), WSF(WS_ZB), WSF(WS_PARTB), tab, has0 ? u0.pm : -1};
              pg8::gemm_phase(lds, g, S, E, TabPre{tab, WSF(WS_PARTB), u0.pm}); }
        } else if (k == 3 || k == 4) {
            if (k == 3) { for (int u = blockIdx.x; u < 8 * NCH; u += G) gla_a_unit(lds, u, l); } else gla_scan(G);
            const unsigned bgen = xcd_barrier_arrive((unsigned*)(ws_ptr() + WS_BAR), bst);
            for (int u = (k == 3 ? 0 : 256) + (int)blockIdx.x; u < (k == 3 ? 256 : 512); u += G) sg_unit(lds, u, l);
            xcd_barrier_wait((unsigned*)(ws_ptr() + WS_BAR), bgen);
            continue;
        } else if (k == 5) {
            for (int u = blockIdx.x; u < 8 * NCH; u += G) gla_c_unit(lds, u, l);
            {
                const unsigned bgen = xcd_barrier_arrive((unsigned*)(ws_ptr() + WS_BAR), bst);
                pg8::Gemm g{WSB(WS_PB) + (size_t)l * MTOK * DPLE, WSB(lo + OFF_WPP), MTOK, DM, DPLE}; S.init(MTOK, DM, G, (int)blockIdx.x);
                EpiStore E{WSB(WS_PP)};
                pg8::gemm_phase(lds, g, S, E, pg8::NoPre{});
                xcd_barrier_wait((unsigned*)(ws_ptr() + WS_BAR), bgen);
                continue;
            }
        } else {
            pg8::Gemm g{WSB(hbo), WSB(lo + OFF_WPG), MTOK, DM, DM}; S.init(MTOK, DM, G, (int)blockIdx.x);
            pg8::Unit u0; const bool has0 = S.next(0, u0); LAS float* tab = (LAS float*)(lds + RSTD_OFF);
            EpiPle E{WSB(hbo), WSB(hbn), WSB(WS_PP), WSF(WS_PARTB), WSF(WS_PARTA), tab, has0 ? u0.pm : -1};
            pg8::gemm_phase(lds, g, S, E, TabPre{tab, WSF(WS_PARTB), u0.pm});
        }
        }
        if (cw >= 0 && c0 < c1) convert_items(lds, c0, c1, cw, cn);
        if (st < 0) { const unsigned bgen = xcd_barrier_arrive((unsigned*)(ws_ptr() + WS_BAR), bst); prologue_p(G); xcd_barrier_wait((unsigned*)(ws_ptr() + WS_BAR), bgen); continue; }
        GRID_BAR();
    }
    {
        const int tid = opaque_tid(), lane = tid & 63, wave = tid >> 6, gw = blockIdx.x * 8 + wave, NGW = G * 8;
        const f32x4* gf = (const f32x4*)in_ptr(I_FIN) + 2 * lane;
        for (int m = 2 * gw; m < MTOK; m += 2 * NGW) {
            float ps[2]; u32x4 w[2][4];
#pragma unroll
            for (int r = 0; r < 2; ++r) { ps[r] = (lane < 32) ? WSF(WS_PARTA)[(size_t)(m + r) * 32 + lane] : 0.f;
                const u32x4* hrow = (const u32x4*)(WSB(WS_HB) + (size_t)(m + r) * DM) + lane;
#pragma unroll
                for (int j = 0; j < 4; ++j) w[r][j] = hrow[64 * j]; }
#pragma unroll
            for (int r = 0; r < 2; ++r) { const float rstd = rsqrtf(wave_sum(ps[r]) * (1.0f / DM) + EPS);
                f32x4* orow = (f32x4*)(out_ptr() + (size_t)(m + r) * DM) + 2 * lane;
#pragma unroll
                for (int j = 0; j < 4; ++j) { orow[128 * j] = unpk_lo(w[r][j]) * rstd * gf[128 * j]; orow[128 * j + 1] = unpk_hi(w[r][j]) * rstd * gf[128 * j + 1]; } }
        }
    }
}

extern "C" void kernel_launch(void* const* d_in, const int* in_sizes, int n_in, void* d_out, int out_size, void* d_ws, size_t ws_size, hipStream_t stream) {
    static int grid = 0;
    if (grid == 0) {
        if (n_in != 21 || out_size != MTOK * DM || ws_size < WS_END) { fprintf(stderr, "kernel_launch: unexpected shapes (n_in %d, out %d, ws %zu < %zu)\n", n_in, out_size, ws_size, (size_t)WS_END); grid = -1; return; }
        int dev = 0, cus = 0, per_cu = 0;
        hipGetDevice(&dev);
        hipDeviceGetAttribute(&cus, hipDeviceAttributeMultiprocessorCount, dev);
        hipFuncSetAttribute((const void*)fwd_megakernel, hipFuncAttributeMaxDynamicSharedMemorySize, LDS_BYTES);
        hipOccupancyMaxActiveBlocksPerMultiprocessor(&per_cu, (const void*)fwd_megakernel, NTHREADS, LDS_BYTES);
        if (per_cu < 1) { fprintf(stderr, "kernel_launch: occupancy query says %d blocks per CU\n", per_cu); per_cu = 1; }
        grid = cus * per_cu;
        (void)hipGetLastError();
    }
    if (grid < 0) return;
    if (hipMemsetAsync((char*)d_ws + WS_BAR, 0, BAR_BYTES, stream) != hipSuccess) { fprintf(stderr, "kernel_launch: memset of barrier words failed\n"); return; }
    Args a{};
    for (int i = 0; i < 21; ++i) a.in[i] = (const float*)d_in[i];
    a.out = (float*)d_out; a.ws = (unsigned char*)d_ws;
    void* args[] = {&a};
    hipError_t e = hipLaunchCooperativeKernel((const void*)fwd_megakernel, dim3(grid), dim3(NTHREADS), args, LDS_BYTES, stream);
    if (e != hipSuccess) fprintf(stderr, "cooperative launch failed: %s (grid %d)\n", hipGetErrorString(e), grid);
}
```

```cpp
#include <hip/hip_runtime.h>
#include <hip/hip_cooperative_groups.h>
#include <cstdio>
#include <cstdint>
namespace cg = cooperative_groups;
#ifndef PROBE_SYNCS
#define PROBE_SYNCS 0
#endif
#ifndef PROBE_PRO
#define PROBE_PRO 0
#endif
#ifndef PROBE_MIX
#define PROBE_MIX 0
#endif
#ifndef PROBE_FFNIN
#define PROBE_FFNIN 0
#endif

#define LAS __attribute__((address_space(3)))
typedef unsigned short bf16_t;
typedef short bf16x8 __attribute__((ext_vector_type(8)));
typedef float f32x4 __attribute__((ext_vector_type(4)));
typedef float f32x2 __attribute__((ext_vector_type(2)));
typedef unsigned u32x4 __attribute__((ext_vector_type(4)));
typedef unsigned u32x2 __attribute__((ext_vector_type(2)));

constexpr int MTOK = 8192, DM = 2048, FF = 5632, NIN = 2 * FF, NMIX = 5136, NMIXP = 5376, MXW = 5120, DPLE = 256, SEQ = 4096;
constexpr float EPS = 1e-6f;
constexpr int NTHREADS = 512;
constexpr int LDS_BYTES = 137216;
constexpr int RSTD_OFF = 135168;

constexpr size_t SZ_W1I = (size_t)NIN * DM * 2, SZ_W1O = (size_t)DM * FF * 2, SZ_WMI = (size_t)NMIXP * DM * 2, SZ_WMO = (size_t)DM * DM * 2, SZ_WPG = (size_t)DM * DM * 2, SZ_WPP = (size_t)DM * DPLE * 2;
constexpr size_t OFF_W1I = 0, OFF_W1O = OFF_W1I + SZ_W1I, OFF_WMI = OFF_W1O + SZ_W1O, OFF_WMO = OFF_WMI + SZ_WMI, OFF_W2I = OFF_WMO + SZ_WMO, OFF_W2O = OFF_W2I + SZ_W1I,
                 OFF_WPG = OFF_W2O + SZ_W1O, OFF_WPP = OFF_WPG + SZ_WPG, SZ_LAYER = OFF_WPP + SZ_WPP;
constexpr size_t WS_HB = 2 * SZ_LAYER;
constexpr size_t WS_ACT = WS_HB + (size_t)MTOK * DM * 2;
constexpr size_t WS_MX = WS_ACT + (size_t)MTOK * FF * 2;
constexpr size_t WS_ZB = WS_MX + (size_t)MTOK * MXW * 2;
constexpr size_t WS_YM = WS_ZB + (size_t)MTOK * 16 * 4;
constexpr size_t WS_PP = WS_YM + (size_t)MTOK * DM * 2;
constexpr size_t WS_PB = WS_PP + (size_t)MTOK * DM * 2;
constexpr size_t WS_PARTA = WS_PB + (size_t)2 * MTOK * DPLE * 2;
constexpr size_t WS_PARTB = WS_PARTA + (size_t)MTOK * 32 * 4;
constexpr size_t WS_ST = WS_PARTB + (size_t)MTOK * 32 * 4;
constexpr size_t WS_DEC = WS_ST + (size_t)8 * 64 * 256 * 128 * 2;
constexpr size_t WS_HB2 = WS_DEC + (size_t)8 * 64 * 128 * 4;
constexpr size_t WS_QT = WS_HB2 + (size_t)MTOK * DM * 2;
constexpr size_t WS_BAR = WS_QT + (size_t)MTOK * 1024 * 2;
constexpr size_t BAR_BYTES = 16384;
constexpr size_t WS_END = WS_BAR + BAR_BYTES;
static_assert((size_t)8 * 64 * 256 * 128 * 4 <= (size_t)MTOK * FF * 2, "UT fits in ACT");

#define LDS_WAIT() asm volatile("s_waitcnt lgkmcnt(0)" ::: "memory")
__device__ __forceinline__ unsigned cvt_pk_bf16(float lo, float hi) { unsigned r; asm volatile("v_cvt_pk_bf16_f32 %0, %1, %2" : "=v"(r) : "v"(lo), "v"(hi)); return r; }
__device__ __forceinline__ float bf_lo(unsigned w) { return __uint_as_float(w << 16); }
__device__ __forceinline__ float bf_hi(unsigned w) { return __uint_as_float(w & 0xffff0000u); }
__device__ __forceinline__ float bf_one(bf16_t h) { return __uint_as_float(((unsigned)h) << 16); }
__device__ __forceinline__ bf16_t f2bf(float f) { return (bf16_t)(cvt_pk_bf16(f, 0.f) & 0xffffu); }
__device__ __forceinline__ float sigmoidf_(float x) { return __builtin_amdgcn_rcpf(1.0f + __expf(-x)); }
__device__ __forceinline__ float siluf_(float x) { return x * sigmoidf_(x); }
__device__ __forceinline__ int opaque_tid() { int t = threadIdx.x; asm volatile("" : "+v"(t)); return t; }
__device__ __forceinline__ float wave_sum(float v) {
#pragma unroll
    for (int o = 1; o < 64; o <<= 1) v += __shfl_xor(v, o);
    return v;
}
__device__ __forceinline__ f32x2 gelu_pk(f32x2 v) {
    const f32x2 av = __builtin_elementwise_abs(v), d = av * 0.2316418882f + 1.0f;
    f32x2 t; t.x = __builtin_amdgcn_rcpf(d.x); t.y = __builtin_amdgcn_rcpf(d.y);
    f32x2 q = t * 0.5307027145f + (-0.7265760135f); q = q * t + 0.7107068705f; q = q * t + (-0.142248368f); q = q * t + 0.127414796f; q = q * t;
    const f32x2 s = (v * v) * (-0.72134752044f);
    f32x2 e; e.x = __builtin_amdgcn_exp2f(s.x); e.y = __builtin_amdgcn_exp2f(s.y);
    const f32x2 m = v * (q * e), r = v - m;
    f32x2 o; o.x = v.x < 0.f ? m.x : r.x; o.y = v.y < 0.f ? m.y : r.y; return o;
}
__device__ __forceinline__ f32x4 gelu4(f32x4 v) { f32x2 a = gelu_pk((f32x2){v[0], v[1]}), b = gelu_pk((f32x2){v[2], v[3]}); return (f32x4){a.x, a.y, b.x, b.y}; }
__device__ __forceinline__ f32x4 silu4(f32x4 v) { return (f32x4){siluf_(v[0]), siluf_(v[1]), siluf_(v[2]), siluf_(v[3])}; }
__device__ __forceinline__ f32x4 sigm4(f32x4 v) { return (f32x4){sigmoidf_(v[0]), sigmoidf_(v[1]), sigmoidf_(v[2]), sigmoidf_(v[3])}; }
__device__ __forceinline__ u32x4 pack8(f32x4 a, f32x4 b) { u32x4 w; w.x = cvt_pk_bf16(a[0], a[1]); w.y = cvt_pk_bf16(a[2], a[3]); w.z = cvt_pk_bf16(b[0], b[1]); w.w = cvt_pk_bf16(b[2], b[3]); return w; }
__device__ __forceinline__ float row_rstd(const float* part, int row, int fq) {
    const f32x4* p = (const f32x4*)(part + (size_t)row * 32 + 8 * fq);
    const f32x4 a = p[0], b = p[1];
    float s = ((a[0] + a[1]) + (a[2] + a[3])) + ((b[0] + b[1]) + (b[2] + b[3]));
    s += __shfl_xor(s, 16); s += __shfl_xor(s, 32);
    return rsqrtf(s * (1.0f / DM) + EPS);
}

namespace pg8 {
constexpr int BM = 256, BK = 64, HALF = 128, HTB = HALF * BK * 2, STAGE_BYTES = 8 * HTB, NXCD = 8, WGM = 4;
__host__ __device__ __forceinline__ int lds_byte(int r, int c) { const int st = (r >> 4) * 2 + (c >> 5), rr = r & 15, cc = c & 31, ob = rr * 64 + cc * 2; return st * 1024 + (ob ^ (((ob >> 9) & 1) << 5)); }
__host__ __device__ __forceinline__ void stage_rc(int b, int& R, int& C) { const int st = b / 1024, sb = b % 1024, swz = sb ^ (((sb >> 9) & 1) << 5); R = (st >> 1) * 16 + swz / 64; C = (st & 1) * 32 + (swz % 64) / 2; }
__host__ __device__ __forceinline__ int perm32(int rho) { const int n = rho >> 4, i = rho & 15; return 8 * (i >> 2) + 4 * n + (i & 3); }
struct Unit { int pm, pn; };
struct Gemm { const bf16_t* A; const bf16_t* Bt; int M, N, K; };
struct StaticOrder {
    int nM, nN, nwg, G, c;
    __device__ void init(int M, int N, int G_, int c_) { nM = M / BM; nN = N / BM; nwg = nM * nN; G = G_; c = c_; }
    __device__ bool next(int i, Unit& u) const {
        const long L = (long)i * G + c; if (L >= nwg) return false;
        int wgid = (int)L; { const int q = nwg / NXCD, r = nwg % NXCD, xcd = wgid % NXCD, off = wgid / NXCD; wgid = (xcd < r ? xcd * (q + 1) : r * (q + 1) + (xcd - r) * q) + off; }
        const int nig = WGM * nN, gid = wgid / nig, fm = gid * WGM, gsz = (nM - fm) < WGM ? (nM - fm) : WGM;
        u.pm = fm + ((wgid % nig) % gsz); u.pn = (wgid % nig) / gsz; return true;
    }
};
struct NoPre { __device__ __forceinline__ void operator()() const {} };
template <class Epi, class Pre>
__device__ __forceinline__ void gemm_phase(LAS unsigned char* lds, const Gemm g, const StaticOrder& S, const Epi& E, const Pre& pre, const bool rev0 = false) {
    const int tid = opaque_tid(), wid = __builtin_amdgcn_readfirstlane(tid >> 6), lane = tid & 63, wr = wid >> 2, wc = wid & 3, fr = lane & 15, fq = lane >> 4;
    int K = g.K; asm volatile("" : "+s"(K)); const int nt = K / BK;
    unsigned voffA[2], voffB[2];
#pragma unroll
    for (int i = 0; i < 2; ++i) { int R, C; stage_rc(tid * 16 + i * 8192, R, C); const int Rb = (R & ~31) + perm32(R & 31);
        voffA[i] = (unsigned)(R * K + C) * 2u; voffB[i] = (unsigned)(Rb * K + C) * 2u; }
    const unsigned kstep = (unsigned)(BK * 2);
    const unsigned hstep = (unsigned)(HALF * 2) * (unsigned)K;
    const unsigned tstep = 2u * hstep;
    const __amdgpu_buffer_rsrc_t rA = __builtin_amdgcn_make_buffer_rsrc((void*)g.A, 0, 0x7ffffffc, 0x00020000), rB = __builtin_amdgcn_make_buffer_rsrc((void*)g.Bt, 0, 0x7ffffffc, 0x00020000);
    const unsigned ldsw = (unsigned)wid * 1024u;
    const int aoff = lds_byte(wr * 64 + fr, fq * 8), boff = lds_byte(wc * 32 + fr, fq * 8);
#define PG8_SA(b, h) (((b) * 2 + (h)) * HTB)
#define PG8_SB(b, h) ((4 + (b) * 2 + (h)) * HTB)
#define PG8_STAGE(bufoff, rsrc, soff, voff) do { const unsigned _so = (soff); _Pragma("unroll") for (int _i = 0; _i < 2; ++_i) \
        __builtin_amdgcn_raw_ptr_buffer_load_lds((rsrc), (LAS void*)(lds + (bufoff) + ldsw + _i * 8192), 16, (voff)[_i], _so, 0, 0); } while (0)
#define PG8_LDA(dst, b, h) do { _Pragma("unroll") for (int m = 0; m < 4; ++m) _Pragma("unroll") for (int k = 0; k < 2; ++k) dst[m][k] = *(const LAS bf16x8*)(lds + PG8_SA(b, h) + aoff + m * 2048 + k * 1024); } while (0)
#define PG8_LDB(dst, b, h) do { _Pragma("unroll") for (int n = 0; n < 2; ++n) _Pragma("unroll") for (int k = 0; k < 2; ++k) dst[n][k] = *(const LAS bf16x8*)(lds + PG8_SB(b, h) + boff + n * 2048 + k * 1024); } while (0)
#define PG8_MMA(ai, bj, At, Bt) do { __builtin_amdgcn_s_setprio(1); _Pragma("unroll") for (int m = 0; m < 4; ++m) _Pragma("unroll") for (int n = 0; n < 2; ++n) _Pragma("unroll") for (int k = 0; k < 2; ++k) \
        acc[ai][bj][m][n] = __builtin_amdgcn_mfma_f32_16x16x32_bf16(Bt[n][k], At[m][k], acc[ai][bj][m][n], 0, 0, 0); __builtin_amdgcn_s_setprio(0); } while (0)
#define PG8_WAIT_V(n) asm volatile("s_waitcnt vmcnt(" #n ")" ::: "memory")
#define PG8_WAIT_L(n) asm volatile("s_waitcnt lgkmcnt(" #n ")" ::: "memory")
#define PG8_BAR __builtin_amdgcn_s_barrier()
#define PG8_SCHED __builtin_amdgcn_sched_barrier(0)
    Unit cur, nxt; int ui = 0;
    if (!S.next(0, cur)) return;
    f32x4 acc[2][2][4][2];
#pragma unroll
    for (int a = 0; a < 2; ++a)
#pragma unroll
        for (int b = 0; b < 2; ++b)
#pragma unroll
            for (int m = 0; m < 4; ++m)
#pragma unroll
                for (int n = 0; n < 2; ++n) acc[a][b][m][n] = (f32x4){0.f, 0.f, 0.f, 0.f};
    bf16x8 At[4][2], B0[2][2], B1[2][2];
    unsigned ks = rev0 ? (0u - kstep) : kstep; const unsigned rv0 = rev0 ? (unsigned)(nt - 1) * kstep : 0u;
    unsigned oA = (unsigned)cur.pm * tstep + rv0, oB = (unsigned)cur.pn * tstep + rv0;

    PG8_STAGE(PG8_SB(0, 0), rB, oB, voffB); PG8_STAGE(PG8_SB(0, 1), rB, oB + hstep, voffB); PG8_STAGE(PG8_SA(0, 0), rA, oA, voffA); PG8_STAGE(PG8_SA(0, 1), rA, oA + hstep, voffA);
    pre();
    if (wr == 1) PG8_BAR;
    PG8_WAIT_V(2); PG8_BAR;
    PG8_STAGE(PG8_SB(1, 0), rB, oB + ks, voffB); PG8_STAGE(PG8_SA(1, 0), rA, oA + ks, voffA); PG8_STAGE(PG8_SB(1, 1), rB, oB + hstep + ks, voffB);
    PG8_WAIT_V(6); PG8_BAR;
    for (;;) {
        const bool has_next = S.next(ui + 1, nxt);
        const unsigned nks = has_next ? (0u - ks) : ks, nrev = (nks != kstep) ? (unsigned)(nt - 1) * kstep : 0u;
        const unsigned noA = has_next ? (unsigned)nxt.pm * tstep + nrev : oA, noB = has_next ? (unsigned)nxt.pn * tstep + nrev : oB;
        for (int t = 0; t < nt; t += 2) {
            const bool last = (t == nt - 2);
            const unsigned tk = (unsigned)t * ks;
            const unsigned a1 = oA + tk + ks;
            const unsigned a2 = last ? noA : oA + tk + 2u * ks, b2 = last ? noB : oB + tk + 2u * ks;
            const unsigned a3 = a2 + (last ? nks : ks), b3 = b2 + (last ? nks : ks);
            PG8_LDB(B0, 0, 0); PG8_LDB(B1, 0, 1); PG8_SCHED; PG8_LDA(At, 0, 0); PG8_STAGE(PG8_SA(1, 1), rA, a1 + hstep, voffA);
            PG8_WAIT_V(8); PG8_WAIT_L(0); PG8_BAR; PG8_MMA(0, 0, At, B0); PG8_MMA(0, 1, At, B1); PG8_BAR; PG8_SCHED;
            PG8_LDA(At, 0, 1); PG8_STAGE(PG8_SB(0, 0), rB, b2, voffB); PG8_STAGE(PG8_SB(0, 1), rB, b2 + hstep, voffB); PG8_STAGE(PG8_SA(0, 0), rA, a2, voffA);
            PG8_WAIT_V(8); PG8_WAIT_L(0); PG8_BAR; PG8_MMA(1, 0, At, B0); PG8_MMA(1, 1, At, B1); PG8_BAR; PG8_SCHED;
            PG8_LDB(B0, 1, 0); PG8_LDB(B1, 1, 1); PG8_SCHED; PG8_LDA(At, 1, 0); PG8_STAGE(PG8_SA(0, 1), rA, a2 + hstep, voffA);
            PG8_WAIT_V(8); PG8_WAIT_L(0); PG8_BAR; PG8_MMA(0, 0, At, B0); PG8_MMA(0, 1, At, B1); PG8_BAR; PG8_SCHED;
            PG8_LDA(At, 1, 1); PG8_STAGE(PG8_SB(1, 0), rB, b3, voffB); PG8_STAGE(PG8_SB(1, 1), rB, b3 + hstep, voffB); PG8_STAGE(PG8_SA(1, 0), rA, a3, voffA);
            PG8_WAIT_V(8); PG8_WAIT_L(0); PG8_BAR; PG8_MMA(1, 0, At, B0); PG8_MMA(1, 1, At, B1); PG8_BAR; PG8_SCHED;
        }
        if (wr == 0) PG8_BAR;
        E(acc, cur, wr, wc, fr, fq);
        if (!has_next) break;
#pragma unroll
        for (int a = 0; a < 2; ++a)
#pragma unroll
            for (int b = 0; b < 2; ++b)
#pragma unroll
                for (int m = 0; m < 4; ++m)
#pragma unroll
                    for (int n = 0; n < 2; ++n) acc[a][b][m][n] = (f32x4){0.f, 0.f, 0.f, 0.f};
        cur = nxt; oA = noA; oB = noB; ks = nks; ++ui;
        if (wr == 1) PG8_BAR;
    }
    PG8_WAIT_V(0);
    PG8_BAR;
#undef PG8_SA
#undef PG8_SB
#undef PG8_STAGE
#undef PG8_LDA
#undef PG8_LDB
#undef PG8_MMA
#undef PG8_WAIT_V
#undef PG8_WAIT_L
#undef PG8_BAR
#undef PG8_SCHED
}
}
using pg8::Unit;
typedef f32x4 AccT[2][2][4][2];

__device__ __forceinline__ void row_rstd8(const float* part, int row0, int fq, float (&rs)[2][4]) {
#pragma unroll
    for (int ai = 0; ai < 2; ++ai) {
        f32x4 pa[4], pb[4];
#pragma unroll
        for (int m = 0; m < 4; ++m) { const f32x4* p = (const f32x4*)(part + (unsigned)((row0 + ai * 128 + m * 16) * 32 + 8 * fq)); pa[m] = p[0]; pb[m] = p[1]; }
#pragma unroll
        for (int m = 0; m < 4; ++m) { const f32x4 a = pa[m], b = pb[m];
            float s = ((a[0] + a[1]) + (a[2] + a[3])) + ((b[0] + b[1]) + (b[2] + b[3]));
            s += __shfl_xor(s, 16); s += __shfl_xor(s, 32);
            rs[ai][m] = rsqrtf(s * (1.0f / DM) + EPS); }
    }
}
__device__ __forceinline__ void fill_rstd_table(LAS float* tab, const float* part, int pm) {
    const int tid = opaque_tid(), row = tid >> 1, half = tid & 1;
    const f32x4* p = (const f32x4*)(part + (unsigned)((pm * 256 + row) * 32 + 16 * half));
    const f32x4 a = p[0], b = p[1], c = p[2], d = p[3];
    float s = (((a[0] + a[1]) + (a[2] + a[3])) + ((b[0] + b[1]) + (b[2] + b[3]))) + (((c[0] + c[1]) + (c[2] + c[3])) + ((d[0] + d[1]) + (d[2] + d[3])));
    s += __shfl_xor(s, 1);
    if (half == 0) tab[row] = rsqrtf(s * (1.0f / DM) + EPS);
    __syncthreads();
}
struct TabPre {
    LAS float* tab; const float* part; int pm;
    __device__ __forceinline__ void operator()() const {
        const int tid = opaque_tid(), row = tid >> 1, half = tid & 1;
        const f32x4* p = (const f32x4*)(part + (unsigned)((pm * 256 + row) * 32 + 16 * half));
        const f32x4 a = p[0], b = p[1], c = p[2], d = p[3];
        float s = (((a[0] + a[1]) + (a[2] + a[3])) + ((b[0] + b[1]) + (b[2] + b[3]))) + (((c[0] + c[1]) + (c[2] + c[3])) + ((d[0] + d[1]) + (d[2] + d[3])));
        s += __shfl_xor(s, 1);
        if (half == 0) tab[row] = rsqrtf(s * (1.0f / DM) + EPS);
    }
};
__device__ __forceinline__ void row_scales(const float* part, const LAS float* tab, int pm0, int pm, int row0, int wr, int fr, int fq, float (&rs)[2][4]) {
    if (pm == pm0) {
#pragma unroll
        for (int ai = 0; ai < 2; ++ai)
#pragma unroll
            for (int m = 0; m < 4; ++m) rs[ai][m] = tab[ai * 128 + wr * 64 + m * 16 + fr];
    } else row_rstd8(part, row0, fq, rs);
}
__device__ __forceinline__ float sumsq8(f32x4 h0, f32x4 h1) { return ((h0[0] * h0[0] + h0[1] * h0[1]) + (h0[2] * h0[2] + h0[3] * h0[3])) + ((h1[0] * h1[0] + h1[1] * h1[1]) + (h1[2] * h1[2] + h1[3] * h1[3])); }
struct EpiSwiglu {
    bf16_t* act; const float* part; const LAS float* tab; int pm0;
    __device__ __forceinline__ void operator()(const AccT& acc, const Unit& u, int wr, int wc, int fr, int fq) const {
        const int row0 = u.pm * 256 + wr * 64 + fr, col0 = u.pn * 128 + wc * 32 + 8 * fq;
        float rs[2][4]; row_scales(part, tab, pm0, u.pm, row0, wr, fr, fq, rs);
#pragma unroll
        for (int ai = 0; ai < 2; ++ai)
#pragma unroll
            for (int m = 0; m < 4; ++m) {
                const int row = row0 + ai * 128 + m * 16; const float s = rs[ai][m], sl = s * -1.4426950408889634f, s2 = s * s;
                const f32x4 g0 = acc[ai][0][m][0], g1 = acc[ai][0][m][1];
                const f32x4 a0 = g0 * sl, a1 = g1 * sl;
                const f32x4 e0 = (f32x4){__builtin_amdgcn_exp2f(a0[0]), __builtin_amdgcn_exp2f(a0[1]), __builtin_amdgcn_exp2f(a0[2]), __builtin_amdgcn_exp2f(a0[3])} + 1.0f;
                const f32x4 e1 = (f32x4){__builtin_amdgcn_exp2f(a1[0]), __builtin_amdgcn_exp2f(a1[1]), __builtin_amdgcn_exp2f(a1[2]), __builtin_amdgcn_exp2f(a1[3])} + 1.0f;
                const f32x4 r0 = (f32x4){__builtin_amdgcn_rcpf(e0[0]), __builtin_amdgcn_rcpf(e0[1]), __builtin_amdgcn_rcpf(e0[2]), __builtin_amdgcn_rcpf(e0[3])};
                const f32x4 r1 = (f32x4){__builtin_amdgcn_rcpf(e1[0]), __builtin_amdgcn_rcpf(e1[1]), __builtin_amdgcn_rcpf(e1[2]), __builtin_amdgcn_rcpf(e1[3])};
                *(u32x4*)(act + (unsigned)(row * FF + col0)) = pack8((g0 * acc[ai][1][m][0]) * s2 * r0, (g1 * acc[ai][1][m][1]) * s2 * r1);
            }
    }
};
__device__ __forceinline__ f32x4 unpk_lo(u32x4 w) { return (f32x4){bf_lo(w.x), bf_hi(w.x), bf_lo(w.y), bf_hi(w.y)}; }
__device__ __forceinline__ f32x4 unpk_hi(u32x4 w) { return (f32x4){bf_lo(w.z), bf_hi(w.z), bf_lo(w.w), bf_hi(w.w)}; }
struct EpiResid {
    bf16_t* hb; float* part; float scale;
    __device__ __forceinline__ void operator()(const AccT& acc, const Unit& u, int wr, int wc, int fr, int fq) const {
        const int row0 = u.pm * 256 + wr * 64 + fr, col0 = u.pn * 256 + wc * 32 + 8 * fq;
        u32x4 hv[2][4][2];
#pragma unroll
        for (int ai = 0; ai < 2; ++ai)
#pragma unroll
            for (int m = 0; m < 4; ++m)
#pragma unroll
                for (int bj = 0; bj < 2; ++bj) hv[ai][m][bj] = *(const u32x4*)(hb + (unsigned)((row0 + ai * 128 + m * 16) * DM + col0 + bj * 128));
#pragma unroll
        for (int ai = 0; ai < 2; ++ai) {
#pragma unroll
            for (int m = 0; m < 4; ++m) {
                const int row = row0 + ai * 128 + m * 16; float ss = 0.f;
#pragma unroll
                for (int bj = 0; bj < 2; ++bj) {
                    const unsigned o = (unsigned)(row * DM + col0 + bj * 128);
                    const f32x4 h0 = unpk_lo(hv[ai][m][bj]) + acc[ai][bj][m][0] * scale, h1 = unpk_hi(hv[ai][m][bj]) + acc[ai][bj][m][1] * scale;
                    *(u32x4*)(hb + o) = pack8(h0, h1);
                    ss += sumsq8(h0, h1);
                }
                ss += __shfl_xor(ss, 16); ss += __shfl_xor(ss, 32);
                if (fq == 0) part[(unsigned)(row * 32 + 4 * u.pn + wc)] = ss;
            }
        }
    }
};
struct EpiMixIn {
    bf16_t* mx; float* zb; const float* part; const LAS float* tab; int pm0;
    __device__ __forceinline__ void operator()(const AccT& acc, const Unit& u, int wr, int wc, int fr, int fq) const {
        const int row0 = u.pm * 256 + wr * 64 + fr, pn = u.pn, col0 = pn * 256 + wc * 32 + 8 * fq;
        float rs[2][4]; row_scales(part, tab, pm0, u.pm, row0, wr, fr, fq, rs);
#pragma unroll
        for (int ai = 0; ai < 2; ++ai)
#pragma unroll
            for (int m = 0; m < 4; ++m) {
                const int row = row0 + ai * 128 + m * 16; const float s = rs[ai][m];
#pragma unroll
                for (int bj = 0; bj < 2; ++bj) {
                    f32x4 v0 = acc[ai][bj][m][0] * s, v1 = acc[ai][bj][m][1] * s;
                    if (pn < 8) { v0 = gelu4(v0); v1 = gelu4(v1); }
                    else if (pn < 10) { v0 = v0 * 0.08838834764831845f; v1 = v1 * 0.08838834764831845f; }
                    else if (pn >= 16 && pn < 20) { v0 = silu4(v0); v1 = silu4(v1); }
                    if (pn < 20) *(u32x4*)(mx + (unsigned)(row * MXW + col0 + bj * 128)) = pack8(v0, v1);
                    else if (bj == 0 && wc == 0 && fq < 2) { float* z = zb + (unsigned)(row * 16 + 8 * fq); *(f32x4*)z = v0; *(f32x4*)(z + 4) = v1; }
                }
            }
    }
};
struct EpiStore {
    bf16_t* o;
    __device__ __forceinline__ void operator()(const AccT& acc, const Unit& u, int wr, int wc, int fr, int fq) const {
        const int row0 = u.pm * 256 + wr * 64 + fr, col0 = u.pn * 256 + wc * 32 + 8 * fq;
#pragma unroll
        for (int ai = 0; ai < 2; ++ai)
#pragma unroll
            for (int m = 0; m < 4; ++m)
                {
#pragma unroll
                  for (int bj = 0; bj < 2; ++bj)
                    *(u32x4*)(o + (unsigned)((row0 + ai * 128 + m * 16) * DM + col0 + bj * 128)) = pack8(acc[ai][bj][m][0], acc[ai][bj][m][1]);
                  asm volatile("" ::: "memory"); }
    }
};
struct EpiPle {
    const bf16_t* hsrc; bf16_t* hdst; const bf16_t* pp; const float* part_in; float* part_out; const LAS float* tab; int pm0;
    __device__ __forceinline__ void operator()(const AccT& acc, const Unit& u, int wr, int wc, int fr, int fq) const {
        const int row0 = u.pm * 256 + wr * 64 + fr, col0 = u.pn * 256 + wc * 32 + 8 * fq;
        float rs[2][4]; row_scales(part_in, tab, pm0, u.pm, row0, wr, fr, fq, rs);
        u32x4 hv[2][2][2], pw[2][2][2];
#define PLE_LOAD(buf, b) do { _Pragma("unroll") for (int mm = 0; mm < 2; ++mm) _Pragma("unroll") for (int bj = 0; bj < 2; ++bj) { \
            const unsigned o_ = (unsigned)((row0 + ((b) >> 1) * 128 + (2 * ((b) & 1) + mm) * 16) * DM + col0 + bj * 128); hv[buf][mm][bj] = *(const u32x4*)(hsrc + o_); pw[buf][mm][bj] = *(const u32x4*)(pp + o_); } } while (0)
        PLE_LOAD(0, 0);
#pragma unroll
        for (int b = 0; b < 4; ++b) {
            const int ai = b >> 1, mp = b & 1, cur = b & 1;
            if (b < 3) { if (cur == 0) PLE_LOAD(1, b + 1); else PLE_LOAD(0, b + 1); }
#pragma unroll
            for (int mm = 0; mm < 2; ++mm) {
                const int m = 2 * mp + mm, row = row0 + ai * 128 + m * 16; const float s = rs[ai][m]; float ss = 0.f;
#pragma unroll
                for (int bj = 0; bj < 2; ++bj) {
                    const unsigned o = (unsigned)(row * DM + col0 + bj * 128);
                    const f32x4 h0 = unpk_lo(hv[cur][mm][bj]) + sigm4(acc[ai][bj][m][0] * s) * unpk_lo(pw[cur][mm][bj]), h1 = unpk_hi(hv[cur][mm][bj]) + sigm4(acc[ai][bj][m][1] * s) * unpk_hi(pw[cur][mm][bj]);
                    *(u32x4*)(hdst + o) = pack8(h0, h1);
                    ss += sumsq8(h0, h1);
                }
                ss += __shfl_xor(ss, 16); ss += __shfl_xor(ss, 32);
                if (fq == 0) part_out[(unsigned)(row * 32 + 4 * u.pn + wc)] = ss;
            }
        }
#undef PLE_LOAD
    }
};

template <int MODE>
__device__ __forceinline__ void conv_item(const float* __restrict__ W, const float* __restrict__ gain, int K, int N, bf16_t* __restrict__ WT, int kb, int nb, LAS float* scr, int lane) {
    const int k0 = kb * 64, n0 = nb * 64, cc = lane & 15, kr = lane >> 4;
    f32x4 v[16];
#pragma unroll
    for (int i = 0; i < 16; ++i) { const int kk = 4 * i + kr, n = n0 + 4 * cc;
        v[i] = (n < N) ? __builtin_nontemporal_load((const f32x4*)(W + (size_t)(k0 + kk) * N + n)) : (f32x4){0.f, 0.f, 0.f, 0.f}; }
#pragma unroll
    for (int i = 0; i < 16; ++i) { const int kk = 4 * i + kr; const float g = gain ? gain[k0 + kk] : 1.0f;
        LAS float* d = scr + kk * 65 + 4 * cc; d[0] = v[i][0] * g; d[1] = v[i][1] * g; d[2] = v[i][2] * g; d[3] = v[i][3] * g; }
    LDS_WAIT();
    const int c = lane & 7, nl = lane >> 3;
#pragma unroll
    for (int j = 0; j < 8; ++j) { const int n = nl + 8 * j; const LAS float* s = scr + (8 * c) * 65 + n;
        u32x4 o; o.x = cvt_pk_bf16(s[0], s[65]); o.y = cvt_pk_bf16(s[130], s[195]); o.z = cvt_pk_bf16(s[260], s[325]); o.w = cvt_pk_bf16(s[390], s[455]);
        const int ng = n0 + n; int row = ng;
        if (MODE == 1) { row = (ng < FF) ? (256 * (ng >> 7) + (ng & 127)) : (256 * ((ng - FF) >> 7) + 128 + ((ng - FF) & 127)); }
        *(u32x4*)(WT + (size_t)row * K + k0 + 8 * c) = o; }
    LDS_WAIT();
}


#define XB_TMO      128
#define XB_XCNT(j)  (256  + 64 * (j))
#define XB_XSUB(j)  (1280 + 64 * (j))
#define XB_XGEN(j)  (2304 + 64 * (j))
#define XB_TOP      3328
#define XB_TOPGEN   3392
#define XCD_BAR_WORDS 3456
#define XB_SPIN_CAP (1u << 22)
__device__ __forceinline__ unsigned xb_ld(unsigned* p)              { return __hip_atomic_load(p, __ATOMIC_RELAXED, __HIP_MEMORY_SCOPE_AGENT); }
__device__ __forceinline__ unsigned xb_add(unsigned* p, unsigned v) { return __hip_atomic_fetch_add(p, v, __ATOMIC_RELAXED, __HIP_MEMORY_SCOPE_AGENT); }
__device__ __forceinline__ unsigned xb_xcc_id() { return (unsigned)__builtin_amdgcn_s_getreg((3 << 11) | 20) & 0xFu; }
#define XB_SPIN(cond, bar) do { unsigned _sp = 0; while (cond) { __builtin_amdgcn_s_sleep(1); \
    if ((++_sp & 255u) == 0u) { if (xb_ld(&(bar)[XB_TMO])) break; if (_sp > XB_SPIN_CAP) { atomicAdd(&(bar)[XB_TMO], 1u); break; } } } } while (0)
__device__ __forceinline__ void xcd_barrier_complete(unsigned* bar, unsigned x, unsigned& nloc, unsigned& nx) {
    const unsigned G = gridDim.x;
    unsigned sum, cnt, mine, sp = 0u;
    for (;;) {
        sum = 0u; cnt = 0u; mine = 0u;
#pragma unroll
        for (unsigned j = 0; j < 16; ++j) { const unsigned c = xb_ld(&bar[XB_XCNT(j)]); sum += c; cnt += (c > 0u) ? 1u : 0u; mine = (j == x) ? c : mine; }
        if (sum == G) break;
        __builtin_amdgcn_s_sleep(1);
        if ((++sp & 255u) == 0u) { if (xb_ld(&bar[XB_TMO])) break; if (sp > XB_SPIN_CAP) { atomicAdd(&bar[XB_TMO], 1u); break; } }
    }
    nloc = mine > 0u ? mine : 1u; nx = cnt > 0u ? cnt : 1u;
}
__device__ __forceinline__ void xcd_barrier(unsigned* bar, volatile LAS unsigned* st) {
    asm volatile("s_waitcnt vmcnt(0)" ::: "memory");
    __syncthreads();
    if (threadIdx.x == 0) {
        const unsigned x = xb_xcc_id();
        __builtin_amdgcn_s_waitcnt(0);
        unsigned nloc = st[0], nx = st[1];
        if (nloc == 0u) { xcd_barrier_complete(bar, x, nloc, nx); st[0] = nloc; st[1] = nx; }
        const unsigned old = xb_add(&bar[XB_XSUB(x)], 1u);
        const unsigned gen = old / nloc;
        if (old + 1u == (gen + 1u) * nloc) {
            __builtin_amdgcn_fence(__ATOMIC_RELEASE, "agent");
            asm volatile("s_waitcnt vmcnt(0)" ::: "memory");
            const unsigned og = xb_add(&bar[XB_TOP], 1u);
            const unsigned tg = og / nx;
            if (og + 1u == (tg + 1u) * nx) xb_add(&bar[XB_TOPGEN], 1u);
            else XB_SPIN(xb_ld(&bar[XB_TOPGEN]) == tg, bar);
            __builtin_amdgcn_fence(__ATOMIC_ACQUIRE, "agent");
            asm volatile("s_waitcnt vmcnt(0)" ::: "memory");
        } else {
            XB_SPIN(xb_ld(&bar[XB_TOPGEN]) == gen, bar);
            __builtin_amdgcn_fence(__ATOMIC_ACQUIRE, "agent");
            asm volatile("s_waitcnt vmcnt(0)" ::: "memory");
        }
    }
    __syncthreads();
}

__device__ __forceinline__ unsigned xcd_barrier_arrive(unsigned* bar, volatile LAS unsigned* st) {
    unsigned gen = 0u;
    asm volatile("s_waitcnt vmcnt(0)" ::: "memory");
    __syncthreads();
    if (threadIdx.x == 0) {
        const unsigned x = xb_xcc_id();
        __builtin_amdgcn_s_waitcnt(0);
        unsigned nloc = st[0], nx = st[1];
        if (nloc == 0u) { xcd_barrier_complete(bar, x, nloc, nx); st[0] = nloc; st[1] = nx; }
        const unsigned old = xb_add(&bar[XB_XSUB(x)], 1u);
        gen = old / nloc;
        if (old + 1u == (gen + 1u) * nloc) {
            __builtin_amdgcn_fence(__ATOMIC_RELEASE, "agent");
            asm volatile("s_waitcnt vmcnt(0)" ::: "memory");
            const unsigned og = xb_add(&bar[XB_TOP], 1u);
            const unsigned tg = og / nx;
            if (og + 1u == (tg + 1u) * nx) xb_add(&bar[XB_TOPGEN], 1u);
        }
    }
    return gen;
}
__device__ __forceinline__ void xcd_barrier_wait(unsigned* bar, unsigned gen) {
    if (threadIdx.x == 0) {
        XB_SPIN(xb_ld(&bar[XB_TOPGEN]) == gen, bar);
        __builtin_amdgcn_fence(__ATOMIC_ACQUIRE, "agent");
        asm volatile("s_waitcnt vmcnt(0)" ::: "memory");
    }
    __syncthreads();
}

struct Args { const float* in[21]; float* out; unsigned char* ws; };
typedef const __attribute__((address_space(4))) char* kptr_t;
__device__ __forceinline__ const float* in_ptr(int i) { int off = i * 8; asm volatile("" : "+s"(off)); kptr_t kp = (kptr_t)__builtin_amdgcn_kernarg_segment_ptr(); return *(const float* const __attribute__((address_space(4)))*)(kp + off); }
__device__ __forceinline__ float* out_ptr() { return (float*)in_ptr(21); }
__device__ __forceinline__ unsigned char* ws_ptr() { return (unsigned char*)in_ptr(22); }
enum { I_X = 0, I_P, I_F1N, I_F1I, I_F1O, I_MXN, I_MXI, I_SGVG, I_SGW, I_SGB, I_GWG, I_GBG, I_GOG, I_MXO, I_F2N, I_F2I, I_F2O, I_PLN, I_PLG, I_PLP, I_FIN };

constexpr int I_1I = (DM / 64) * (NIN / 64), I_1O = (FF / 64) * (DM / 64), I_MI = (DM / 64) * (NMIXP / 64), I_MO = (DM / 64) * (DM / 64), I_PP = (DPLE / 64) * (DM / 64);
constexpr int PER_LAYER = 2 * I_1I + 2 * I_1O + I_MI + 2 * I_MO + I_PP;
constexpr int CV_PRO = I_1I;
constexpr int CV_E0 = CV_PRO + 8000;
constexpr int CV_E2 = CV_E0 + 5120;
constexpr int CV_E7 = PER_LAYER + I_1I;
constexpr int CV_E10 = CV_E7 + 8000, CV_E12 = CV_E10 + 5120, CV_E17 = 2 * PER_LAYER;
static_assert(CV_E0 >= CV_PRO + I_1O + I_MI && CV_E2 >= CV_PRO + I_1O + I_MI + I_PP + I_MO + I_1I && CV_E2 <= CV_E7 && CV_E10 >= CV_E7 + I_1O + I_MI && CV_E12 >= CV_E7 + I_1O + I_MI + I_PP + I_MO + I_1I && CV_E12 <= CV_E17, "every weight range is converted at least one barrier before its first use");
__device__ __forceinline__ void convert_items(LAS unsigned char* lds, int it0, int it1, int worker, int nworkers) {
    const int tid = opaque_tid(), lane = tid & 63, wave = __builtin_amdgcn_readfirstlane(tid >> 6);
    LAS float* scr = (LAS float*)(lds + wave * 16640);
    unsigned char* ws = ws_ptr();
    for (int it = it0 + worker * 8 + wave; it < it1; it += nworkers * 8) {
        const int l = (it >= PER_LAYER) ? 1 : 0; int r = it - l * PER_LAYER;
        unsigned char* wl = ws + (size_t)l * SZ_LAYER;
#define CONV(MODE, src, gain, K, N, NPAD, dstoff) { constexpr int nbk = (NPAD) / 64, cnt = ((K) / 64) * nbk; \
        if (r < cnt) { conv_item<MODE>((src) + (size_t)l * (K) * (N), (gain), (K), (N), (bf16_t*)(wl + (dstoff)), r / nbk, r % nbk, scr, lane); continue; } r -= cnt; }
        CONV(1, in_ptr(I_F1I), in_ptr(I_F1N) + l * DM, DM, NIN, NIN, OFF_W1I)
        CONV(0, in_ptr(I_F1O), (const float*)nullptr, FF, DM, DM, OFF_W1O)
        CONV(0, in_ptr(I_MXI), in_ptr(I_MXN) + l * DM, DM, NMIX, NMIXP, OFF_WMI)
        CONV(0, in_ptr(I_PLP), (const float*)nullptr, DPLE, DM, DM, OFF_WPP)
        CONV(0, in_ptr(I_MXO), (const float*)nullptr, DM, DM, DM, OFF_WMO)
        CONV(1, in_ptr(I_F2I), in_ptr(I_F2N) + l * DM, DM, NIN, NIN, OFF_W2I)
        CONV(0, in_ptr(I_F2O), (const float*)nullptr, FF, DM, DM, OFF_W2O)
        CONV(0, in_ptr(I_PLG), in_ptr(I_PLN) + l * DM, DM, DM, DM, OFF_WPG)
#undef CONV
    }
}
__device__ __forceinline__ void prologue(LAS unsigned char* lds, int G) {
    const int tid = opaque_tid(), lane = tid & 63, wave = __builtin_amdgcn_readfirstlane(tid >> 6);
    const int gw = blockIdx.x * 8 + wave, NGW = G * 8;
    unsigned char* ws = ws_ptr();
    bf16_t* HB = (bf16_t*)(ws + WS_HB); float* PA = (float*)(ws + WS_PARTA);
    for (int m = 2 * gw; m < MTOK; m += 2 * NGW) {
        f32x4 v[2][8]; float sq[2];
#pragma unroll
        for (int r = 0; r < 2; ++r) { const f32x4* xr = (const f32x4*)(in_ptr(I_X) + (size_t)(m + r) * DM) + lane;
#pragma unroll
            for (int j = 0; j < 8; ++j) v[r][j] = xr[64 * j]; }
#pragma unroll
        for (int r = 0; r < 2; ++r) { float t = 0.f;
#pragma unroll
            for (int j = 0; j < 8; ++j) t += (v[r][j][0] * v[r][j][0] + v[r][j][1] * v[r][j][1]) + (v[r][j][2] * v[r][j][2] + v[r][j][3] * v[r][j][3]);
            sq[r] = wave_sum(t); }
#pragma unroll
        for (int r = 0; r < 2; ++r) { u32x2* o8 = (u32x2*)(HB + (size_t)(m + r) * DM) + lane;
#pragma unroll
            for (int j = 0; j < 8; ++j) { u32x2 w; w.x = cvt_pk_bf16(v[r][j][0], v[r][j][1]); w.y = cvt_pk_bf16(v[r][j][2], v[r][j][3]); o8[64 * j] = w; }
            if (lane < 32) PA[(size_t)(m + r) * 32 + lane] = (lane == 0) ? sq[r] : 0.f; }
    }
}
__device__ __forceinline__ void prologue_p(int G) {
    const int tid = opaque_tid(), lane = tid & 63, wave = __builtin_amdgcn_readfirstlane(tid >> 6);
    const int gw = blockIdx.x * 8 + wave, NGW = G * 8;
    unsigned char* ws = ws_ptr();
    bf16_t* PB = (bf16_t*)(ws + WS_PB);
    for (int m = 4 * gw; m < 2 * MTOK; m += 4 * NGW) {
        f32x4 v[4];
#pragma unroll
        for (int r = 0; r < 4; ++r) v[r] = *((const f32x4*)(in_ptr(I_P) + (size_t)(m + r) * DPLE) + lane);
#pragma unroll
        for (int r = 0; r < 4; ++r) { u32x2 w; w.x = cvt_pk_bf16(v[r][0], v[r][1]); w.y = cvt_pk_bf16(v[r][2], v[r][3]); *((u32x2*)(PB + (size_t)(m + r) * DPLE) + lane) = w; }
    }
}

#define MFMA16(X, Y, C) __builtin_amdgcn_mfma_f32_16x16x32_bf16((X), (Y), (C), 0, 0, 0)
__device__ __forceinline__ void sg_unit(LAS unsigned char* lds, int unit, int l) {
    const int tid = opaque_tid(), lane = tid & 63, w = __builtin_amdgcn_readfirstlane(tid >> 6), fr = lane & 15, fq = lane >> 4;
    const int h = unit & 7, t0 = (unit >> 3) * 128;
    LAS bf16_t* Vt = (LAS bf16_t*)lds;
    LAS bf16_t* Wl = (LAS bf16_t*)(lds + 34816);
    LAS float* red = (LAS float*)(lds + 69632);
    const bf16_t* MX = (const bf16_t*)(ws_ptr() + WS_MX); bf16_t* YM = (bf16_t*)(ws_ptr() + WS_YM);
    const int s = tid & 127, part = tid >> 7;
    float x[32];
    {
        const u32x4* src = (const u32x4*)(MX + (size_t)(t0 + s) * MXW + 1024 + h * 128 + 32 * part);
        float sum = 0.f, sq = 0.f;
#pragma unroll
        for (int j = 0; j < 4; ++j) { const u32x4 q = src[j];
            x[8 * j + 0] = bf_lo(q.x); x[8 * j + 1] = bf_hi(q.x); x[8 * j + 2] = bf_lo(q.y); x[8 * j + 3] = bf_hi(q.y);
            x[8 * j + 4] = bf_lo(q.z); x[8 * j + 5] = bf_hi(q.z); x[8 * j + 6] = bf_lo(q.w); x[8 * j + 7] = bf_hi(q.w); }
#pragma unroll
        for (int e = 0; e < 32; ++e) { sum += x[e]; sq += x[e] * x[e]; }
        red[part * 128 + s] = sum; red[512 + part * 128 + s] = sq;
    }
    {
        const float* wsrc = in_ptr(I_SGW) + (size_t)(l * 8 + h) * 128 * 128;
#pragma unroll
        for (int j = 0; j < 8; ++j) { const int idx = tid + 512 * j, t = idx >> 5, c4 = idx & 31;
            f32x4 wv = *(const f32x4*)(wsrc + t * 128 + 4 * c4);
#pragma unroll
            for (int e = 0; e < 4; ++e) if (4 * c4 + e > t) wv[e] = 0.f;
            u32x2 o; o.x = cvt_pk_bf16(wv[0], wv[1]); o.y = cvt_pk_bf16(wv[2], wv[3]);
            *(LAS u32x2*)(Wl + t * 136 + 4 * c4) = o; }
    }
    __syncthreads();
    {
        const float sum = (red[s] + red[128 + s]) + (red[256 + s] + red[384 + s]), sq = (red[512 + s] + red[640 + s]) + (red[768 + s] + red[896 + s]);
        const float mean = sum * (1.0f / 128.0f), var = fmaxf(sq * (1.0f / 128.0f) - mean * mean, 0.f), rstd = rsqrtf(var + EPS);
        const float* gv = in_ptr(I_SGVG) + l * 1024 + h * 128 + 32 * part;
#pragma unroll
        for (int e = 0; e < 32; ++e) Vt[(32 * part + e) * 136 + s] = f2bf((x[e] - mean) * rstd * gv[e]);
    }
    __syncthreads();
    const int tq = 16 * w + fr; const float bias = in_ptr(I_SGB)[(l * 8 + h) * 128 + tq];
    const bf16_t* urow = MX + (size_t)(t0 + tq) * MXW + h * 128 + 4 * fq;
    u32x2 uuv[8];
#pragma unroll
    for (int nt = 0; nt < 8; ++nt) uuv[nt] = *(const u32x2*)(urow + 16 * nt);
    f32x4 acc[8];
#pragma unroll
    for (int nt = 0; nt < 8; ++nt) acc[nt] = (f32x4){0.f, 0.f, 0.f, 0.f};
    const int nks = (w >> 1) + 1;
    for (int ks = 0; ks < nks; ++ks) {
        const bf16x8 A = *(const LAS bf16x8*)(Wl + (16 * w + fr) * 136 + 32 * ks + 8 * fq);
#pragma unroll
        for (int nt = 0; nt < 8; ++nt) { const bf16x8 B = *(const LAS bf16x8*)(Vt + (16 * nt + fr) * 136 + 32 * ks + 8 * fq); acc[nt] = MFMA16(B, A, acc[nt]); }
    }
    {
        bf16_t* yrow = YM + (size_t)(t0 + tq) * DM + h * 128 + 4 * fq;
#pragma unroll
        for (int nt = 0; nt < 8; ++nt) { const u32x2 uu = uuv[nt];
            u32x2 o; o.x = cvt_pk_bf16(bf_lo(uu.x) * (acc[nt][0] + bias), bf_hi(uu.x) * (acc[nt][1] + bias)); o.y = cvt_pk_bf16(bf_lo(uu.y) * (acc[nt][2] + bias), bf_hi(uu.y) * (acc[nt][3] + bias));
            *(u32x2*)(yrow + 16 * nt) = o; }
    }
    __syncthreads();
}

constexpr int GL_QS = 0, GL_KS = 17408, GL_VT = 34816, GL_PS = 71680, GL_KD = 80896, GL_ZS = 99328, GL_TOT = 103424, GL_SS = 105472;
constexpr int GC = 128, NCH = SEQ / GC;
constexpr int GA_VT = 0, GA_KD = 69632, GA_ZS = 104448, GA_TOT = 112640;
constexpr int GCc_VT = 0, GCc_PS = 69632;
__device__ __forceinline__ void gla_a_unit(LAS unsigned char* lds, int unit, int l) {
    const int tid = opaque_tid(), lane = tid & 63, w = __builtin_amdgcn_readfirstlane(tid >> 6), fr = lane & 15, fq = lane >> 4;
    const int bh = unit / NCH, c = unit - bh * NCH, b = bh >> 2, h = bh & 3, t0 = b * SEQ + GC * c;
    LAS bf16_t* Vt = (LAS bf16_t*)(lds + GA_VT); LAS bf16_t* KDt = (LAS bf16_t*)(lds + GA_KD);
    LAS float* Zs = (LAS float*)(lds + GA_ZS); LAS float* TOT = (LAS float*)(lds + GA_TOT);
    const bf16_t* MX = (const bf16_t*)(ws_ptr() + WS_MX); const float* ZB = (const float*)(ws_ptr() + WS_ZB);
    *(LAS f32x4*)(Zs + tid * 4) = *(const f32x4*)(ZB + (size_t)t0 * 16 + tid * 4);
#pragma unroll
    for (int p = 0; p < 2; ++p) {
        const u32x4* src = (const u32x4*)(MX + (size_t)(t0 + 64 * p + lane) * MXW + 3072 + h * 256 + 32 * w);
#pragma unroll
        for (int j = 0; j < 4; ++j) { const u32x4 q = src[j]; LAS bf16_t* d = Vt + (32 * w + 8 * j) * 136 + 64 * p + lane;
            d[0] = (bf16_t)(q.x & 0xffff); d[136] = (bf16_t)(q.x >> 16); d[272] = (bf16_t)(q.y & 0xffff); d[408] = (bf16_t)(q.y >> 16);
            d[544] = (bf16_t)(q.z & 0xffff); d[680] = (bf16_t)(q.z >> 16); d[816] = (bf16_t)(q.w & 0xffff); d[952] = (bf16_t)(q.w >> 16); }
    }
    const int kk = tid & 127, tg = tid >> 7;
    bf16_t qraw[32], kraw[32];
    { const bf16_t* qsrc0 = MX + (size_t)(t0 + 32 * tg) * MXW + 2048 + h * 128 + kk;
#pragma unroll
      for (int i = 0; i < 32; ++i) { kraw[i] = qsrc0[(size_t)i * MXW + 512]; qraw[i] = qsrc0[(size_t)i * MXW]; } }
    float wg[16];
#pragma unroll
    for (int r = 0; r < 16; ++r) wg[r] = in_ptr(I_GWG)[(size_t)(l * 16 + r) * 512 + h * 128 + kk];
    const float bg = in_ptr(I_GBG)[l * 512 + h * 128 + kk];
    __syncthreads();
    float bl[32]; float cum = 0.f;
#pragma unroll
    for (int i = 0; i < 32; ++i) { const LAS float* z = Zs + (32 * tg + i) * 16; float g = bg;
#pragma unroll
        for (int r = 0; r < 16; ++r) g += z[r] * wg[r];
        const float ls = fminf(g, 0.f) - __logf(1.0f + __expf(-fabsf(g)));
        cum += ls * (1.0f / 16.0f); bl[i] = cum; }
    TOT[tg * 128 + kk] = cum;
    __syncthreads();
    float off = 0.f, blast = 0.f;
#pragma unroll
    for (int g = 0; g < 4; ++g) { const float t = TOT[g * 128 + kk]; blast += t; if (g < tg) off += t; }
    bf16_t* qt = (bf16_t*)(ws_ptr() + WS_QT) + (size_t)(t0 + 32 * tg) * 1024 + h * 256 + kk;
#pragma unroll
    for (int i8 = 0; i8 < 4; ++i8) {
        float kd[8];
#pragma unroll
        for (int e = 0; e < 8; ++e) { const int i = 8 * i8 + e; const float bb = bl[i] + off, kv = bf_one(kraw[i]);
            kd[e] = kv * __expf(blast - bb);
            qt[(size_t)i * 1024] = f2bf(bf_one(qraw[i]) * __expf(bb)); qt[(size_t)i * 1024 + 128] = f2bf(kv * __expf(-bb)); }
        u32x4 o; o.x = cvt_pk_bf16(kd[0], kd[1]); o.y = cvt_pk_bf16(kd[2], kd[3]); o.z = cvt_pk_bf16(kd[4], kd[5]); o.w = cvt_pk_bf16(kd[6], kd[7]);
        *(LAS u32x4*)(KDt + kk * 136 + 32 * tg + 8 * i8) = o;
    }
    if (tg == 0) ((float*)(ws_ptr() + WS_DEC))[(size_t)(bh * NCH + c) * 128 + kk] = __expf(blast);
    __syncthreads();
    f32x4 acc[2][8];
#pragma unroll
    for (int mi = 0; mi < 2; ++mi)
#pragma unroll
        for (int nt = 0; nt < 8; ++nt) acc[mi][nt] = (f32x4){0.f, 0.f, 0.f, 0.f};
#pragma unroll
    for (int ks = 0; ks < 4; ++ks) {
        const bf16x8 A0 = *(const LAS bf16x8*)(Vt + (32 * w + fr) * 136 + 32 * ks + 8 * fq), A1 = *(const LAS bf16x8*)(Vt + (32 * w + 16 + fr) * 136 + 32 * ks + 8 * fq);
#pragma unroll
        for (int nt = 0; nt < 8; ++nt) { const bf16x8 B = *(const LAS bf16x8*)(KDt + (16 * nt + fr) * 136 + 32 * ks + 8 * fq);
            acc[0][nt] = MFMA16(B, A0, acc[0][nt]); acc[1][nt] = MFMA16(B, A1, acc[1][nt]); }
    }
    float* UT = (float*)(ws_ptr() + WS_ACT) + (size_t)(bh * NCH + c) * 256 * 128;
#pragma unroll
    for (int mi = 0; mi < 2; ++mi)
#pragma unroll
        for (int nt = 0; nt < 8; ++nt) *(f32x4*)(UT + (size_t)(32 * w + 16 * mi + fr) * 128 + 16 * nt + 4 * fq) = acc[mi][nt];
    __syncthreads();
}
__device__ __forceinline__ void gla_c_unit(LAS unsigned char* lds, int unit, int l) {
    const int tid = opaque_tid(), lane = tid & 63, w = __builtin_amdgcn_readfirstlane(tid >> 6), fr = lane & 15, fq = lane >> 4;
    const int bh = unit / NCH, c = unit - bh * NCH, b = bh >> 2, h = bh & 3, t0 = b * SEQ + GC * c;
    LAS bf16_t* Vt = (LAS bf16_t*)(lds + GCc_VT); LAS bf16_t* Ps = (LAS bf16_t*)(lds + GCc_PS);
    const bf16_t* MX = (const bf16_t*)(ws_ptr() + WS_MX);
    const int i = 16 * w + fr;
    const bf16_t* QT = (const bf16_t*)(ws_ptr() + WS_QT) + (size_t)t0 * 1024 + h * 256;
    bf16x8 Aq[4];
#pragma unroll
    for (int ks = 0; ks < 4; ++ks) Aq[ks] = *(const bf16x8*)(QT + (size_t)i * 1024 + 32 * ks + 8 * fq);
#pragma unroll
    for (int p = 0; p < 2; ++p) {
        const u32x4* src = (const u32x4*)(MX + (size_t)(t0 + 64 * p + lane) * MXW + 3072 + h * 256 + 32 * w);
#pragma unroll
        for (int j = 0; j < 4; ++j) { const u32x4 q = src[j]; LAS bf16_t* d = Vt + (32 * w + 8 * j) * 136 + 64 * p + lane;
            d[0] = (bf16_t)(q.x & 0xffff); d[136] = (bf16_t)(q.x >> 16); d[272] = (bf16_t)(q.y & 0xffff); d[408] = (bf16_t)(q.y >> 16);
            d[544] = (bf16_t)(q.z & 0xffff); d[680] = (bf16_t)(q.z >> 16); d[816] = (bf16_t)(q.w & 0xffff); d[952] = (bf16_t)(q.w >> 16); }
    }
#pragma unroll
    for (int nt = 0; nt < 8; ++nt) {
        f32x4 p = (f32x4){0.f, 0.f, 0.f, 0.f};
        if (nt <= w) {
#pragma unroll
            for (int ks = 0; ks < 4; ++ks) { const bf16x8 B = *(const bf16x8*)(QT + (size_t)(16 * nt + fr) * 1024 + 128 + 32 * ks + 8 * fq); p = MFMA16(B, Aq[ks], p); }
        }
        const int j0 = 16 * nt + 4 * fq;
#pragma unroll
        for (int jj = 0; jj < 4; ++jj) if (j0 + jj > i) p[jj] = 0.f;
        u32x2 o; o.x = cvt_pk_bf16(p[0], p[1]); o.y = cvt_pk_bf16(p[2], p[3]);
        *(LAS u32x2*)(Ps + i * 136 + j0) = o;
    }
    f32x4 acc[16];
#pragma unroll
    for (int nt = 0; nt < 16; ++nt) acc[nt] = (f32x4){0.f, 0.f, 0.f, 0.f};
    const bf16_t* ST = (const bf16_t*)(ws_ptr() + WS_ST) + (size_t)(bh * NCH + c) * 256 * 128;
#pragma unroll
    for (int nt = 0; nt < 16; ++nt) { const bf16_t* srow = ST + (size_t)(16 * nt + fr) * 128 + 8 * fq;
#pragma unroll
        for (int ks = 0; ks < 4; ++ks) { const bf16x8 B = *(const bf16x8*)(srow + 32 * ks); acc[nt] = MFMA16(B, Aq[ks], acc[nt]); } }
    const float* og = in_ptr(I_GOG) + l * 1024 + h * 256 + 4 * fq;
    const bf16_t* rrow = MX + (size_t)(t0 + i) * MXW + 4096 + h * 256 + 4 * fq;
    f32x4 g4v[16]; u32x2 rrv[16];
#pragma unroll
    for (int nt = 0; nt < 16; ++nt) { g4v[nt] = *(const f32x4*)(og + 16 * nt); rrv[nt] = *(const u32x2*)(rrow + 16 * nt); }
    __syncthreads();
    const int nks = (w >> 1) + 1;
#pragma unroll
    for (int ks = 0; ks < 4; ++ks) if (ks < nks) { const bf16x8 A = *(const LAS bf16x8*)(Ps + i * 136 + 32 * ks + 8 * fq);
#pragma unroll
        for (int nt = 0; nt < 16; ++nt) { const bf16x8 B = *(const LAS bf16x8*)(Vt + (16 * nt + fr) * 136 + 32 * ks + 8 * fq); acc[nt] = MFMA16(B, A, acc[nt]); } }
    float ss = 0.f;
#pragma unroll
    for (int nt = 0; nt < 16; ++nt) ss += (acc[nt][0] * acc[nt][0] + acc[nt][1] * acc[nt][1]) + (acc[nt][2] * acc[nt][2] + acc[nt][3] * acc[nt][3]);
    ss += __shfl_xor(ss, 16); ss += __shfl_xor(ss, 32);
    const float rstd = rsqrtf(ss * (1.0f / 256.0f) + EPS);
    bf16_t* yrow = (bf16_t*)(ws_ptr() + WS_YM) + (size_t)(t0 + i) * DM + 1024 + h * 256 + 4 * fq;
#pragma unroll
    for (int nt = 0; nt < 16; ++nt) { const f32x4 g4 = g4v[nt]; const u32x2 rr = rrv[nt];
        u32x2 o; o.x = cvt_pk_bf16(acc[nt][0] * rstd * g4[0] * bf_lo(rr.x), acc[nt][1] * rstd * g4[1] * bf_hi(rr.x));
        o.y = cvt_pk_bf16(acc[nt][2] * rstd * g4[2] * bf_lo(rr.y), acc[nt][3] * rstd * g4[3] * bf_hi(rr.y));
        *(u32x2*)(yrow + 16 * nt) = o; }
    __syncthreads();
}

__device__ __forceinline__ void gla_scan(int G) {
    const float* UT = (const float*)(ws_ptr() + WS_ACT); const float* DEC = (const float*)(ws_ptr() + WS_DEC); bf16_t* ST = (bf16_t*)(ws_ptr() + WS_ST);
    for (int idx = blockIdx.x * NTHREADS + opaque_tid(); idx < 8 * 256 * 64; idx += G * NTHREADS) {
        const int e = idx * 2, kk = e & 127, dv = (e >> 7) & 255, bh = e >> 15;
        f32x2 S = (f32x2){0.f, 0.f};
        const size_t base = ((size_t)bh * NCH * 256 + dv) * 128 + kk;
#pragma unroll 8
        for (int c = 0; c < NCH; ++c) {
            const f32x2 u = *(const f32x2*)(UT + base + (size_t)c * 256 * 128);
            const f32x2 d = *(const f32x2*)(DEC + (size_t)(bh * NCH + c) * 128 + kk);
            *(unsigned*)(ST + base + (size_t)c * 256 * 128) = cvt_pk_bf16(S[0], S[1]);
            S = S * d + u;
        }
    }
}

__global__ void __launch_bounds__(NTHREADS, 2) fwd_megakernel(Args a) {
    extern __shared__ __attribute__((aligned(16))) unsigned char lds_raw[];
    LAS unsigned char* lds = (LAS unsigned char*)lds_raw;
    cg::grid_group grid = cg::this_grid();
    const int G = gridDim.x;
    volatile LAS unsigned* bst = (volatile LAS unsigned*)(lds + 134144);
    if (threadIdx.x < 2) bst[threadIdx.x] = 0u;
    __syncthreads();
    if (threadIdx.x == 0) (void)xb_add(&((unsigned*)(ws_ptr() + WS_BAR))[XB_XCNT(xb_xcc_id())], 1u);
#define GRID_BAR() xcd_barrier((unsigned*)(ws_ptr() + WS_BAR), bst)
#define WSB(off) ((bf16_t*)(ws_ptr() + (off)))
#define WSF(off) ((float*)(ws_ptr() + (off)))
    if (G == 0x7fffffff) grid.sync();
    const bool win = (G == 256);
    int probe_rep = PROBE_MIX;
    for (int st = -1; st < 20; ++st) {
        int c0 = 0, c1 = 0, cw = (int)blockIdx.x, cn = G;
        if (st < 0) { prologue(lds, G); c1 = win ? CV_PRO : 2 * PER_LAYER; }
        else {
        const int l = st / 10, k = st - 10 * l;
        if (win) {
            if (k == 0) { c0 = l ? CV_E7 : CV_PRO; c1 = l ? CV_E10 : CV_E0; cw -= 128; cn = 128; }
            else if (k == 2) { c0 = l ? CV_E10 : CV_E0; c1 = l ? CV_E12 : CV_E2; cw -= 160; cn = 96; }
            else if (k == 7) { c0 = l ? CV_E12 : CV_E2; c1 = l ? CV_E17 : CV_E7; cw -= 128; cn = 128; }
        }
        const size_t lo = (size_t)l * SZ_LAYER;
        const size_t hbo = (l & 1) ? WS_HB2 : WS_HB, hbn = (l & 1) ? WS_HB : WS_HB2;
        pg8::StaticOrder S;
        if (k == 0 || k == 7) {
            pg8::Gemm g{WSB(hbo), WSB(lo + (k == 0 ? OFF_W1I : OFF_W2I)), MTOK, NIN, DM}; S.init(MTOK, NIN, G, (int)blockIdx.x);
            pg8::Unit u0; const bool has0 = S.next(0, u0); LAS float* tab = (LAS float*)(lds + RSTD_OFF);
            EpiSwiglu E{WSB(WS_ACT), WSF(WS_PARTA), tab, has0 ? u0.pm : -1};
            pg8::gemm_phase(lds, g, S, E, TabPre{tab, WSF(WS_PARTA), u0.pm});
        } else if (k == 1 || k == 6 || k == 8) {
            pg8::Gemm g{(k == 6) ? WSB(WS_YM) : WSB(WS_ACT), WSB(lo + (k == 1 ? OFF_W1O : (k == 6 ? OFF_WMO : OFF_W2O))), MTOK, DM, (k == 6) ? DM : FF}; S.init(MTOK, DM, G, (int)blockIdx.x);
            EpiResid E{WSB(hbo), (k == 6) ? WSF(WS_PARTA) : WSF(WS_PARTB), (k == 6) ? 1.0f : 0.5f};
            pg8::gemm_phase(lds, g, S, E, pg8::NoPre{}, k != 6);
        } else if (k == 2) {
            { pg8::Gemm g{WSB(hbo), WSB(lo + OFF_WMI), MTOK, NMIXP, DM}; S.init(MTOK, NMIXP, G, (int)blockIdx.x);
              pg8::Unit u0; const bool has0 = S.next(0, u0); LAS float* tab = (LAS float*)(lds + RSTD_OFF);
              EpiMixIn E{WSB(WS_MX), WSF(WS_ZB), WSF(WS_PARTB), tab, has0 ? u0.pm : -1};
              pg8::gemm_phase(lds, g, S, E, TabPre{tab, WSF(WS_PARTB), u0.pm}); }
        } else if (k == 3 || k == 4) {
            if (k == 3) { for (int u = blockIdx.x; u < 8 * NCH; u += G) gla_a_unit(lds, u, l); } else gla_scan(G);
            const unsigned bgen = xcd_barrier_arrive((unsigned*)(ws_ptr() + WS_BAR), bst);
            for (int u = (k == 3 ? 0 : 256) + (int)blockIdx.x; u < (k == 3 ? 256 : 512); u += G) sg_unit(lds, u, l);
            xcd_barrier_wait((unsigned*)(ws_ptr() + WS_BAR), bgen);
            continue;
        } else if (k == 5) {
            for (int u = blockIdx.x; u < 8 * NCH; u += G) gla_c_unit(lds, u, l);
            {
                const unsigned bgen = xcd_barrier_arrive((unsigned*)(ws_ptr() + WS_BAR), bst);
                pg8::Gemm g{WSB(WS_PB) + (size_t)l * MTOK * DPLE, WSB(lo + OFF_WPP), MTOK, DM, DPLE}; S.init(MTOK, DM, G, (int)blockIdx.x);
                EpiStore E{WSB(WS_PP)};
                pg8::gemm_phase(lds, g, S, E, pg8::NoPre{});
                xcd_barrier_wait((unsigned*)(ws_ptr() + WS_BAR), bgen);
                continue;
            }
        } else {
            pg8::Gemm g{WSB(hbo), WSB(lo + OFF_WPG), MTOK, DM, DM}; S.init(MTOK, DM, G, (int)blockIdx.x);
            pg8::Unit u0; const bool has0 = S.next(0, u0); LAS float* tab = (LAS float*)(lds + RSTD_OFF);
            EpiPle E{WSB(hbo), WSB(hbn), WSB(WS_PP), WSF(WS_PARTB), WSF(WS_PARTA), tab, has0 ? u0.pm : -1};
            pg8::gemm_phase(lds, g, S, E, TabPre{tab, WSF(WS_PARTB), u0.pm});
        }
        }
        if (cw >= 0 && c0 < c1) convert_items(lds, c0, c1, cw, cn);
        if (st < 0) { const unsigned bgen = xcd_barrier_arrive((unsigned*)(ws_ptr() + WS_BAR), bst); prologue_p(G); xcd_barrier_wait((unsigned*)(ws_ptr() + WS_BAR), bgen); continue; }
        GRID_BAR();
    }
    {
        const int tid = opaque_tid(), lane = tid & 63, wave = tid >> 6, gw = blockIdx.x * 8 + wave, NGW = G * 8;
        const f32x4* gf = (const f32x4*)in_ptr(I_FIN) + 2 * lane;
        for (int m = 2 * gw; m < MTOK; m += 2 * NGW) {
            float ps[2]; u32x4 w[2][4];
#pragma unroll
            for (int r = 0; r < 2; ++r) { ps[r] = (lane < 32) ? WSF(WS_PARTA)[(size_t)(m + r) * 32 + lane] : 0.f;
                const u32x4* hrow = (const u32x4*)(WSB(WS_HB) + (size_t)(m + r) * DM) + lane;
#pragma unroll
                for (int j = 0; j < 4; ++j) w[r][j] = hrow[64 * j]; }
#pragma unroll
            for (int r = 0; r < 2; ++r) { const float rstd = rsqrtf(wave_sum(ps[r]) * (1.0f / DM) + EPS);
                f32x4* orow = (f32x4*)(out_ptr() + (size_t)(m + r) * DM) + 2 * lane;
#pragma unroll
                for (int j = 0; j < 4; ++j) { orow[128 * j] = unpk_lo(w[r][j]) * rstd * gf[128 * j]; orow[128 * j + 1] = unpk_hi(w[r][j]) * rstd * gf[128 * j + 1]; } }
        }
    }
}

extern "C" void kernel_launch(void* const* d_in, const int* in_sizes, int n_in, void* d_out, int out_size, void* d_ws, size_t ws_size, hipStream_t stream) {
    static int grid = 0;
    if (grid == 0) {
        if (n_in != 21 || out_size != MTOK * DM || ws_size < WS_END) { fprintf(stderr, "kernel_launch: unexpected shapes (n_in %d, out %d, ws %zu < %zu)\n", n_in, out_size, ws_size, (size_t)WS_END); grid = -1; return; }
        int dev = 0, cus = 0, per_cu = 0;
        hipGetDevice(&dev);
        hipDeviceGetAttribute(&cus, hipDeviceAttributeMultiprocessorCount, dev);
        hipFuncSetAttribute((const void*)fwd_megakernel, hipFuncAttributeMaxDynamicSharedMemorySize, LDS_BYTES);
        hipOccupancyMaxActiveBlocksPerMultiprocessor(&per_cu, (const void*)fwd_megakernel, NTHREADS, LDS_BYTES);
        if (per_cu < 1) { fprintf(stderr, "kernel_launch: occupancy query says %d blocks per CU\n", per_cu); per_cu = 1; }
        grid = cus * per_cu;
        (void)hipGetLastError();
    }
    if (grid < 0) return;
    if (hipMemsetAsync((char*)d_ws + WS_BAR, 0, BAR_BYTES, stream) != hipSuccess) { fprintf(stderr, "kernel_launch: memset of barrier words failed\n"); return; }
    Args a{};
    for (int i = 0; i < 21; ++i) a.in[i] = (const float*)d_in[i];
    a.out = (float*)d_out; a.ws = (unsigned char*)d_ws;
    void* args[] = {&a};
    hipError_t e = hipLaunchCooperativeKernel((const void*)fwd_megakernel, dim3(grid), dim3(NTHREADS), args, LDS_BYTES, stream);
    if (e != hipSuccess) fprintf(stderr, "cooperative launch failed: %s (grid %d)\n", hipGetErrorString(e), grid);
}
```

```cpp
#include <hip/hip_runtime.h>
#include <hip/hip_cooperative_groups.h>
#include <cstdio>
#include <cstdint>
namespace cg = cooperative_groups;
#ifndef PROBE_SYNCS
#define PROBE_SYNCS 0
#endif
#ifndef PROBE_PRO
#define PROBE_PRO 0
#endif
#ifndef PROBE_MIX
#define PROBE_MIX 0
#endif
#ifndef PROBE_FFNIN
#define PROBE_FFNIN 0
#endif

#define LAS __attribute__((address_space(3)))
typedef unsigned short bf16_t;
typedef short bf16x8 __attribute__((ext_vector_type(8)));
typedef float f32x4 __attribute__((ext_vector_type(4)));
typedef float f32x2 __attribute__((ext_vector_type(2)));
typedef unsigned u32x4 __attribute__((ext_vector_type(4)));
typedef unsigned u32x2 __attribute__((ext_vector_type(2)));

constexpr int MTOK = 8192, DM = 2048, FF = 5632, NIN = 2 * FF, NMIX = 5136, NMIXP = 5376, MXW = 5120, DPLE = 256, SEQ = 4096;
constexpr float EPS = 1e-6f;
constexpr int NTHREADS = 512;
constexpr int LDS_BYTES = 137216;
constexpr int RSTD_OFF = 135168;

constexpr size_t SZ_W1I = (size_t)NIN * DM * 2, SZ_W1O = (size_t)DM * FF * 2, SZ_WMI = (size_t)NMIXP * DM * 2, SZ_WMO = (size_t)DM * DM * 2, SZ_WPG = (size_t)DM * DM * 2, SZ_WPP = (size_t)DM * DPLE * 2;
constexpr size_t OFF_W1I = 0, OFF_W1O = OFF_W1I + SZ_W1I, OFF_WMI = OFF_W1O + SZ_W1O, OFF_WMO = OFF_WMI + SZ_WMI, OFF_W2I = OFF_WMO + SZ_WMO, OFF_W2O = OFF_W2I + SZ_W1I,
                 OFF_WPG = OFF_W2O + SZ_W1O, OFF_WPP = OFF_WPG + SZ_WPG, SZ_LAYER = OFF_WPP + SZ_WPP;
constexpr size_t WS_HB = 2 * SZ_LAYER;
constexpr size_t WS_ACT = WS_HB + (size_t)MTOK * DM * 2;
constexpr size_t WS_MX = WS_ACT + (size_t)MTOK * FF * 2;
constexpr size_t WS_ZB = WS_MX + (size_t)MTOK * MXW * 2;
constexpr size_t WS_YM = WS_ZB + (size_t)MTOK * 16 * 4;
constexpr size_t WS_PP = WS_YM + (size_t)MTOK * DM * 2;
constexpr size_t WS_PB = WS_PP + (size_t)MTOK * DM * 2;
constexpr size_t WS_PARTA = WS_PB + (size_t)2 * MTOK * DPLE * 2;
constexpr size_t WS_PARTB = WS_PARTA + (size_t)MTOK * 32 * 4;
constexpr size_t WS_ST = WS_PARTB + (size_t)MTOK * 32 * 4;
constexpr size_t WS_DEC = WS_ST + (size_t)8 * 64 * 256 * 128 * 2;
constexpr size_t WS_HB2 = WS_DEC + (size_t)8 * 64 * 128 * 4;
constexpr size_t WS_QT = WS_HB2 + (size_t)MTOK * DM * 2;
constexpr size_t WS_BAR = WS_QT + (size_t)MTOK * 1024 * 2;
constexpr size_t BAR_BYTES = 16384;
constexpr size_t WS_END = WS_BAR + BAR_BYTES;
static_assert((size_t)8 * 64 * 256 * 128 * 4 <= (size_t)MTOK * FF * 2, "UT fits in ACT");

#define LDS_WAIT() asm volatile("s_waitcnt lgkmcnt(0)" ::: "memory")
__device__ __forceinline__ unsigned cvt_pk_bf16(float lo, float hi) { unsigned r; asm volatile("v_cvt_pk_bf16_f32 %0, %1, %2" : "=v"(r) : "v"(lo), "v"(hi)); return r; }
__device__ __forceinline__ float bf_lo(unsigned w) { return __uint_as_float(w << 16); }
__device__ __forceinline__ float bf_hi(unsigned w) { return __uint_as_float(w & 0xffff0000u); }
__device__ __forceinline__ float bf_one(bf16_t h) { return __uint_as_float(((unsigned)h) << 16); }
__device__ __forceinline__ bf16_t f2bf(float f) { return (bf16_t)(cvt_pk_bf16(f, 0.f) & 0xffffu); }
__device__ __forceinline__ float sigmoidf_(float x) { return __builtin_amdgcn_rcpf(1.0f + __expf(-x)); }
__device__ __forceinline__ float siluf_(float x) { return x * sigmoidf_(x); }
__device__ __forceinline__ int opaque_tid() { int t = threadIdx.x; asm volatile("" : "+v"(t)); return t; }
__device__ __forceinline__ float wave_sum(float v) {
#pragma unroll
    for (int o = 1; o < 64; o <<= 1) v += __shfl_xor(v, o);
    return v;
}
__device__ __forceinline__ f32x2 gelu_pk(f32x2 v) {
    const f32x2 av = __builtin_elementwise_abs(v), d = av * 0.2316418882f + 1.0f;
    f32x2 t; t.x = __builtin_amdgcn_rcpf(d.x); t.y = __builtin_amdgcn_rcpf(d.y);
    f32x2 q = t * 0.5307027145f + (-0.7265760135f); q = q * t + 0.7107068705f; q = q * t + (-0.142248368f); q = q * t + 0.127414796f; q = q * t;
    const f32x2 s = (v * v) * (-0.72134752044f);
    f32x2 e; e.x = __builtin_amdgcn_exp2f(s.x); e.y = __builtin_amdgcn_exp2f(s.y);
    const f32x2 m = v * (q * e), r = v - m;
    f32x2 o; o.x = v.x < 0.f ? m.x : r.x; o.y = v.y < 0.f ? m.y : r.y; return o;
}
__device__ __forceinline__ f32x4 gelu4(f32x4 v) { f32x2 a = gelu_pk((f32x2){v[0], v[1]}), b = gelu_pk((f32x2){v[2], v[3]}); return (f32x4){a.x, a.y, b.x, b.y}; }
__device__ __forceinline__ f32x4 silu4(f32x4 v) { return (f32x4){siluf_(v[0]), siluf_(v[1]), siluf_(v[2]), siluf_(v[3])}; }
__device__ __forceinline__ f32x4 sigm4(f32x4 v) { return (f32x4){sigmoidf_(v[0]), sigmoidf_(v[1]), sigmoidf_(v[2]), sigmoidf_(v[3])}; }
__device__ __forceinline__ u32x4 pack8(f32x4 a, f32x4 b) { u32x4 w; w.x = cvt_pk_bf16(a[0], a[1]); w.y = cvt_pk_bf16(a[2], a[3]); w.z = cvt_pk_bf16(b[0], b[1]); w.w = cvt_pk_bf16(b[2], b[3]); return w; }
__device__ __forceinline__ float row_rstd(const float* part, int row, int fq) {
    const f32x4* p = (const f32x4*)(part + (size_t)row * 32 + 8 * fq);
    const f32x4 a = p[0], b = p[1];
    float s = ((a[0] + a[1]) + (a[2] + a[3])) + ((b[0] + b[1]) + (b[2] + b[3]));
    s += __shfl_xor(s, 16); s += __shfl_xor(s, 32);
    return rsqrtf(s * (1.0f / DM) + EPS);
}

namespace pg8 {
constexpr int BM = 256, BK = 64, HALF = 128, HTB = HALF * BK * 2, STAGE_BYTES = 8 * HTB, NXCD = 8, WGM = 4;
__host__ __device__ __forceinline__ int lds_byte(int r, int c) { const int st = (r >> 4) * 2 + (c >> 5), rr = r & 15, cc = c & 31, ob = rr * 64 + cc * 2; return st * 1024 + (ob ^ (((ob >> 9) & 1) << 5)); }
__host__ __device__ __forceinline__ void stage_rc(int b, int& R, int& C) { const int st = b / 1024, sb = b % 1024, swz = sb ^ (((sb >> 9) & 1) << 5); R = (st >> 1) * 16 + swz / 64; C = (st & 1) * 32 + (swz % 64) / 2; }
__host__ __device__ __forceinline__ int perm32(int rho) { const int n = rho >> 4, i = rho & 15; return 8 * (i >> 2) + 4 * n + (i & 3); }
struct Unit { int pm, pn; };
struct Gemm { const bf16_t* A; const bf16_t* Bt; int M, N, K; };
struct StaticOrder {
    int nM, nN, nwg, G, c;
    __device__ void init(int M, int N, int G_, int c_) { nM = M / BM; nN = N / BM; nwg = nM * nN; G = G_; c = c_; }
    __device__ bool next(int i, Unit& u) const {
        const long L = (long)i * G + c; if (L >= nwg) return false;
        int wgid = (int)L; { const int q = nwg / NXCD, r = nwg % NXCD, xcd = wgid % NXCD, off = wgid / NXCD; wgid = (xcd < r ? xcd * (q + 1) : r * (q + 1) + (xcd - r) * q) + off; }
        const int nig = WGM * nN, gid = wgid / nig, fm = gid * WGM, gsz = (nM - fm) < WGM ? (nM - fm) : WGM;
        u.pm = fm + ((wgid % nig) % gsz); u.pn = (wgid % nig) / gsz; return true;
    }
};
struct NoPre { __device__ __forceinline__ void operator()() const {} };
template <class Epi, class Pre>
__device__ __forceinline__ void gemm_phase(LAS unsigned char* lds, const Gemm g, const StaticOrder& S, const Epi& E, const Pre& pre, const bool rev0 = false) {
    const int tid = opaque_tid(), wid = __builtin_amdgcn_readfirstlane(tid >> 6), lane = tid & 63, wr = wid >> 2, wc = wid & 3, fr = lane & 15, fq = lane >> 4;
    int K = g.K; asm volatile("" : "+s"(K)); const int nt = K / BK;
    unsigned voffA[2], voffB[2];
#pragma unroll
    for (int i = 0; i < 2; ++i) { int R, C; stage_rc(tid * 16 + i * 8192, R, C); const int Rb = (R & ~31) + perm32(R & 31);
        voffA[i] = (unsigned)(R * K + C) * 2u; voffB[i] = (unsigned)(Rb * K + C) * 2u; }
    const unsigned kstep = (unsigned)(BK * 2);
    const unsigned hstep = (unsigned)(HALF * 2) * (unsigned)K;
    const unsigned tstep = 2u * hstep;
    const __amdgpu_buffer_rsrc_t rA = __builtin_amdgcn_make_buffer_rsrc((void*)g.A, 0, 0x7ffffffc, 0x00020000), rB = __builtin_amdgcn_make_buffer_rsrc((void*)g.Bt, 0, 0x7ffffffc, 0x00020000);
    const unsigned ldsw = (unsigned)wid * 1024u;
    const int aoff = lds_byte(wr * 64 + fr, fq * 8), boff = lds_byte(wc * 32 + fr, fq * 8);
#define PG8_SA(b, h) (((b) * 2 + (h)) * HTB)
#define PG8_SB(b, h) ((4 + (b) * 2 + (h)) * HTB)
#define PG8_STAGE(bufoff, rsrc, soff, voff) do { const unsigned _so = (soff); _Pragma("unroll") for (int _i = 0; _i < 2; ++_i) \
        __builtin_amdgcn_raw_ptr_buffer_load_lds((rsrc), (LAS void*)(lds + (bufoff) + ldsw + _i * 8192), 16, (voff)[_i], _so, 0, 0); } while (0)
#define PG8_LDA(dst, b, h) do { _Pragma("unroll") for (int m = 0; m < 4; ++m) _Pragma("unroll") for (int k = 0; k < 2; ++k) dst[m][k] = *(const LAS bf16x8*)(lds + PG8_SA(b, h) + aoff + m * 2048 + k * 1024); } while (0)
#define PG8_LDB(dst, b, h) do { _Pragma("unroll") for (int n = 0; n < 2; ++n) _Pragma("unroll") for (int k = 0; k < 2; ++k) dst[n][k] = *(const LAS bf16x8*)(lds + PG8_SB(b, h) + boff + n * 2048 + k * 1024); } while (0)
#define PG8_MMA(ai, bj, At, Bt) do { __builtin_amdgcn_s_setprio(1); _Pragma("unroll") for (int m = 0; m < 4; ++m) _Pragma("unroll") for (int n = 0; n < 2; ++n) _Pragma("unroll") for (int k = 0; k < 2; ++k) \
        acc[ai][bj][m][n] = __builtin_amdgcn_mfma_f32_16x16x32_bf16(Bt[n][k], At[m][k], acc[ai][bj][m][n], 0, 0, 0); __builtin_amdgcn_s_setprio(0); } while (0)
#define PG8_WAIT_V(n) asm volatile("s_waitcnt vmcnt(" #n ")" ::: "memory")
#define PG8_WAIT_L(n) asm volatile("s_waitcnt lgkmcnt(" #n ")" ::: "memory")
#define PG8_BAR __builtin_amdgcn_s_barrier()
#define PG8_SCHED __builtin_amdgcn_sched_barrier(0)
    Unit cur, nxt; int ui = 0;
    if (!S.next(0, cur)) return;
    f32x4 acc[2][2][4][2];
#pragma unroll
    for (int a = 0; a < 2; ++a)
#pragma unroll
        for (int b = 0; b < 2; ++b)
#pragma unroll
            for (int m = 0; m < 4; ++m)
#pragma unroll
                for (int n = 0; n < 2; ++n) acc[a][b][m][n] = (f32x4){0.f, 0.f, 0.f, 0.f};
    bf16x8 At[4][2], B0[2][2], B1[2][2];
    unsigned ks = rev0 ? (0u - kstep) : kstep; const unsigned rv0 = rev0 ? (unsigned)(nt - 1) * kstep : 0u;
    unsigned oA = (unsigned)cur.pm * tstep + rv0, oB = (unsigned)cur.pn * tstep + rv0;

    PG8_STAGE(PG8_SB(0, 0), rB, oB, voffB); PG8_STAGE(PG8_SB(0, 1), rB, oB + hstep, voffB); PG8_STAGE(PG8_SA(0, 0), rA, oA, voffA); PG8_STAGE(PG8_SA(0, 1), rA, oA + hstep, voffA);
    pre();
    if (wr == 1) PG8_BAR;
    PG8_WAIT_V(2); PG8_BAR;
    PG8_STAGE(PG8_SB(1, 0), rB, oB + ks, voffB); PG8_STAGE(PG8_SA(1, 0), rA, oA + ks, voffA); PG8_STAGE(PG8_SB(1, 1), rB, oB + hstep + ks, voffB);
    PG8_WAIT_V(6); PG8_BAR;
    for (;;) {
        const bool has_next = S.next(ui + 1, nxt);
        const unsigned nks = has_next ? (0u - ks) : ks, nrev = (nks != kstep) ? (unsigned)(nt - 1) * kstep : 0u;
        const unsigned noA = has_next ? (unsigned)nxt.pm * tstep + nrev : oA, noB = has_next ? (unsigned)nxt.pn * tstep + nrev : oB;
        for (int t = 0; t < nt; t += 2) {
            const bool last = (t == nt - 2);
            const unsigned tk = (unsigned)t * ks;
            const unsigned a1 = oA + tk + ks;
            const unsigned a2 = last ? noA : oA + tk + 2u * ks, b2 = last ? noB : oB + tk + 2u * ks;
            const unsigned a3 = a2 + (last ? nks : ks), b3 = b2 + (last ? nks : ks);
            PG8_LDB(B0, 0, 0); PG8_LDB(B1, 0, 1); PG8_SCHED; PG8_LDA(At, 0, 0); PG8_STAGE(PG8_SA(1, 1), rA, a1 + hstep, voffA);
            PG8_WAIT_V(8); PG8_WAIT_L(0); PG8_BAR; PG8_MMA(0, 0, At, B0); PG8_MMA(0, 1, At, B1); PG8_BAR; PG8_SCHED;
            PG8_LDA(At, 0, 1); PG8_STAGE(PG8_SB(0, 0), rB, b2, voffB); PG8_STAGE(PG8_SB(0, 1), rB, b2 + hstep, voffB); PG8_STAGE(PG8_SA(0, 0), rA, a2, voffA);
            PG8_WAIT_V(8); PG8_WAIT_L(0); PG8_BAR; PG8_MMA(1, 0, At, B0); PG8_MMA(1, 1, At, B1); PG8_BAR; PG8_SCHED;
            PG8_LDB(B0, 1, 0); PG8_LDB(B1, 1, 1); PG8_SCHED; PG8_LDA(At, 1, 0); PG8_STAGE(PG8_SA(0, 1), rA, a2 + hstep, voffA);
            PG8_WAIT_V(8); PG8_WAIT_L(0); PG8_BAR; PG8_MMA(0, 0, At, B0); PG8_MMA(0, 1, At, B1); PG8_BAR; PG8_SCHED;
            PG8_LDA(At, 1, 1); PG8_STAGE(PG8_SB(1, 0), rB, b3, voffB); PG8_STAGE(PG8_SB(1, 1), rB, b3 + hstep, voffB); PG8_STAGE(PG8_SA(1, 0), rA, a3, voffA);
            PG8_WAIT_V(8); PG8_WAIT_L(0); PG8_BAR; PG8_MMA(1, 0, At, B0); PG8_MMA(1, 1, At, B1); PG8_BAR; PG8_SCHED;
        }
        if (wr == 0) PG8_BAR;
        E(acc, cur, wr, wc, fr, fq);
        if (!has_next) break;
#pragma unroll
        for (int a = 0; a < 2; ++a)
#pragma unroll
            for (int b = 0; b < 2; ++b)
#pragma unroll
                for (int m = 0; m < 4; ++m)
#pragma unroll
                    for (int n = 0; n < 2; ++n) acc[a][b][m][n] = (f32x4){0.f, 0.f, 0.f, 0.f};
        cur = nxt; oA = noA; oB = noB; ks = nks; ++ui;
        if (wr == 1) PG8_BAR;
    }
    PG8_WAIT_V(0);
    PG8_BAR;
#undef PG8_SA
#undef PG8_SB
#undef PG8_STAGE
#undef PG8_LDA
#undef PG8_LDB
#undef PG8_MMA
#undef PG8_WAIT_V
#undef PG8_WAIT_L
#undef PG8_BAR
#undef PG8_SCHED
}
}
using pg8::Unit;
typedef f32x4 AccT[2][2][4][2];

__device__ __forceinline__ void row_rstd8(const float* part, int row0, int fq, float (&rs)[2][4]) {
#pragma unroll
    for (int ai = 0; ai < 2; ++ai) {
        f32x4 pa[4], pb[4];
#pragma unroll
        for (int m = 0; m < 4; ++m) { const f32x4* p = (const f32x4*)(part + (unsigned)((row0 + ai * 128 + m * 16) * 32 + 8 * fq)); pa[m] = p[0]; pb[m] = p[1]; }
#pragma unroll
        for (int m = 0; m < 4; ++m) { const f32x4 a = pa[m], b = pb[m];
            float s = ((a[0] + a[1]) + (a[2] + a[3])) + ((b[0] + b[1]) + (b[2] + b[3]));
            s += __shfl_xor(s, 16); s += __shfl_xor(s, 32);
            rs[ai][m] = rsqrtf(s * (1.0f / DM) + EPS); }
    }
}
__device__ __forceinline__ void fill_rstd_table(LAS float* tab, const float* part, int pm) {
    const int tid = opaque_tid(), row = tid >> 1, half = tid & 1;
    const f32x4* p = (const f32x4*)(part + (unsigned)((pm * 256 + row) * 32 + 16 * half));
    const f32x4 a = p[0], b = p[1], c = p[2], d = p[3];
    float s = (((a[0] + a[1]) + (a[2] + a[3])) + ((b[0] + b[1]) + (b[2] + b[3]))) + (((c[0] + c[1]) + (c[2] + c[3])) + ((d[0] + d[1]) + (d[2] + d[3])));
    s += __shfl_xor(s, 1);
    if (half == 0) tab[row] = rsqrtf(s * (1.0f / DM) + EPS);
    __syncthreads();
}
struct TabPre {
    LAS float* tab; const float* part; int pm;
    __device__ __forceinline__ void operator()() const {
        const int tid = opaque_tid(), row = tid >> 1, half = tid & 1;
        const f32x4* p = (const f32x4*)(part + (unsigned)((pm * 256 + row) * 32 + 16 * half));
        const f32x4 a = p[0], b = p[1], c = p[2], d = p[3];
        float s = (((a[0] + a[1]) + (a[2] + a[3])) + ((b[0] + b[1]) + (b[2] + b[3]))) + (((c[0] + c[1]) + (c[2] + c[3])) + ((d[0] + d[1]) + (d[2] + d[3])));
        s += __shfl_xor(s, 1);
        if (half == 0) tab[row] = rsqrtf(s * (1.0f / DM) + EPS);
    }
};
__device__ __forceinline__ void row_scales(const float* part, const LAS float* tab, int pm0, int pm, int row0, int wr, int fr, int fq, float (&rs)[2][4]) {
    if (pm == pm0) {
#pragma unroll
        for (int ai = 0; ai < 2; ++ai)
#pragma unroll
            for (int m = 0; m < 4; ++m) rs[ai][m] = tab[ai * 128 + wr * 64 + m * 16 + fr];
    } else row_rstd8(part, row0, fq, rs);
}
__device__ __forceinline__ float sumsq8(f32x4 h0, f32x4 h1) { return ((h0[0] * h0[0] + h0[1] * h0[1]) + (h0[2] * h0[2] + h0[3] * h0[3])) + ((h1[0] * h1[0] + h1[1] * h1[1]) + (h1[2] * h1[2] + h1[3] * h1[3])); }
struct EpiSwiglu {
    bf16_t* act; const float* part; const LAS float* tab; int pm0;
    __device__ __forceinline__ void operator()(const AccT& acc, const Unit& u, int wr, int wc, int fr, int fq) const {
        const int row0 = u.pm * 256 + wr * 64 + fr, col0 = u.pn * 128 + wc * 32 + 8 * fq;
        float rs[2][4]; row_scales(part, tab, pm0, u.pm, row0, wr, fr, fq, rs);
#pragma unroll
        for (int ai = 0; ai < 2; ++ai)
#pragma unroll
            for (int m = 0; m < 4; ++m) {
                const int row = row0 + ai * 128 + m * 16; const float s = rs[ai][m], sl = s * -1.4426950408889634f, s2 = s * s;
                const f32x4 g0 = acc[ai][0][m][0], g1 = acc[ai][0][m][1];
                const f32x4 a0 = g0 * sl, a1 = g1 * sl;
                const f32x4 e0 = (f32x4){__builtin_amdgcn_exp2f(a0[0]), __builtin_amdgcn_exp2f(a0[1]), __builtin_amdgcn_exp2f(a0[2]), __builtin_amdgcn_exp2f(a0[3])} + 1.0f;
                const f32x4 e1 = (f32x4){__builtin_amdgcn_exp2f(a1[0]), __builtin_amdgcn_exp2f(a1[1]), __builtin_amdgcn_exp2f(a1[2]), __builtin_amdgcn_exp2f(a1[3])} + 1.0f;
                const f32x4 r0 = (f32x4){__builtin_amdgcn_rcpf(e0[0]), __builtin_amdgcn_rcpf(e0[1]), __builtin_amdgcn_rcpf(e0[2]), __builtin_amdgcn_rcpf(e0[3])};
                const f32x4 r1 = (f32x4){__builtin_amdgcn_rcpf(e1[0]), __builtin_amdgcn_rcpf(e1[1]), __builtin_amdgcn_rcpf(e1[2]), __builtin_amdgcn_rcpf(e1[3])};
                *(u32x4*)(act + (unsigned)(row * FF + col0)) = pack8((g0 * acc[ai][1][m][0]) * s2 * r0, (g1 * acc[ai][1][m][1]) * s2 * r1);
            }
    }
};
__device__ __forceinline__ f32x4 unpk_lo(u32x4 w) { return (f32x4){bf_lo(w.x), bf_hi(w.x), bf_lo(w.y), bf_hi(w.y)}; }
__device__ __forceinline__ f32x4 unpk_hi(u32x4 w) { return (f32x4){bf_lo(w.z), bf_hi(w.z), bf_lo(w.w), bf_hi(w.w)}; }
struct EpiResid {
    bf16_t* hb; float* part; float scale;
    __device__ __forceinline__ void operator()(const AccT& acc, const Unit& u, int wr, int wc, int fr, int fq) const {
        const int row0 = u.pm * 256 + wr * 64 + fr, col0 = u.pn * 256 + wc * 32 + 8 * fq;
        u32x4 hv[2][4][2];
#pragma unroll
        for (int ai = 0; ai < 2; ++ai)
#pragma unroll
            for (int m = 0; m < 4; ++m)
#pragma unroll
                for (int bj = 0; bj < 2; ++bj) hv[ai][m][bj] = *(const u32x4*)(hb + (unsigned)((row0 + ai * 128 + m * 16) * DM + col0 + bj * 128));
#pragma unroll
        for (int ai = 0; ai < 2; ++ai) {
#pragma unroll
            for (int m = 0; m < 4; ++m) {
                const int row = row0 + ai * 128 + m * 16; float ss = 0.f;
#pragma unroll
                for (int bj = 0; bj < 2; ++bj) {
                    const unsigned o = (unsigned)(row * DM + col0 + bj * 128);
                    const f32x4 h0 = unpk_lo(hv[ai][m][bj]) + acc[ai][bj][m][0] * scale, h1 = unpk_hi(hv[ai][m][bj]) + acc[ai][bj][m][1] * scale;
                    *(u32x4*)(hb + o) = pack8(h0, h1);
                    ss += sumsq8(h0, h1);
                }
                ss += __shfl_xor(ss, 16); ss += __shfl_xor(ss, 32);
                if (fq == 0) part[(unsigned)(row * 32 + 4 * u.pn + wc)] = ss;
            }
        }
    }
};
struct EpiMixIn {
    bf16_t* mx; float* zb; const float* part; const LAS float* tab; int pm0;
    __device__ __forceinline__ void operator()(const AccT& acc, const Unit& u, int wr, int wc, int fr, int fq) const {
        const int row0 = u.pm * 256 + wr * 64 + fr, pn = u.pn, col0 = pn * 256 + wc * 32 + 8 * fq;
        float rs[2][4]; row_scales(part, tab, pm0, u.pm, row0, wr, fr, fq, rs);
#pragma unroll
        for (int ai = 0; ai < 2; ++ai)
#pragma unroll
            for (int m = 0; m < 4; ++m) {
                const int row = row0 + ai * 128 + m * 16; const float s = rs[ai][m];
#pragma unroll
                for (int bj = 0; bj < 2; ++bj) {
                    f32x4 v0 = acc[ai][bj][m][0] * s, v1 = acc[ai][bj][m][1] * s;
                    if (pn < 8) { v0 = gelu4(v0); v1 = gelu4(v1); }
                    else if (pn < 10) { v0 = v0 * 0.08838834764831845f; v1 = v1 * 0.08838834764831845f; }
                    else if (pn >= 16 && pn < 20) { v0 = silu4(v0); v1 = silu4(v1); }
                    if (pn < 20) *(u32x4*)(mx + (unsigned)(row * MXW + col0 + bj * 128)) = pack8(v0, v1);
                    else if (bj == 0 && wc == 0 && fq < 2) { float* z = zb + (unsigned)(row * 16 + 8 * fq); *(f32x4*)z = v0; *(f32x4*)(z + 4) = v1; }
                }
            }
    }
};
struct EpiStore {
    bf16_t* o;
    __device__ __forceinline__ void operator()(const AccT& acc, const Unit& u, int wr, int wc, int fr, int fq) const {
        const int row0 = u.pm * 256 + wr * 64 + fr, col0 = u.pn * 256 + wc * 32 + 8 * fq;
#pragma unroll
        for (int ai = 0; ai < 2; ++ai)
#pragma unroll
            for (int m = 0; m < 4; ++m)
                {
#pragma unroll
                  for (int bj = 0; bj < 2; ++bj)
                    *(u32x4*)(o + (unsigned)((row0 + ai * 128 + m * 16) * DM + col0 + bj * 128)) = pack8(acc[ai][bj][m][0], acc[ai][bj][m][1]);
                  asm volatile("" ::: "memory"); }
    }
};
struct EpiPle {
    const bf16_t* hsrc; bf16_t* hdst; const bf16_t* pp; const float* part_in; float* part_out; const LAS float* tab; int pm0;
    __device__ __forceinline__ void operator()(const AccT& acc, const Unit& u, int wr, int wc, int fr, int fq) const {
        const int row0 = u.pm * 256 + wr * 64 + fr, col0 = u.pn * 256 + wc * 32 + 8 * fq;
        float rs[2][4]; row_scales(part_in, tab, pm0, u.pm, row0, wr, fr, fq, rs);
        u32x4 hv[2][2][2], pw[2][2][2];
#define PLE_LOAD(buf, b) do { _Pragma("unroll") for (int mm = 0; mm < 2; ++mm) _Pragma("unroll") for (int bj = 0; bj < 2; ++bj) { \
            const unsigned o_ = (unsigned)((row0 + ((b) >> 1) * 128 + (2 * ((b) & 1) + mm) * 16) * DM + col0 + bj * 128); hv[buf][mm][bj] = *(const u32x4*)(hsrc + o_); pw[buf][mm][bj] = *(const u32x4*)(pp + o_); } } while (0)
        PLE_LOAD(0, 0);
#pragma unroll
        for (int b = 0; b < 4; ++b) {
            const int ai = b >> 1, mp = b & 1, cur = b & 1;
            if (b < 3) { if (cur == 0) PLE_LOAD(1, b + 1); else PLE_LOAD(0, b + 1); }
#pragma unroll
            for (int mm = 0; mm < 2; ++mm) {
                const int m = 2 * mp + mm, row = row0 + ai * 128 + m * 16; const float s = rs[ai][m]; float ss = 0.f;
#pragma unroll
                for (int bj = 0; bj < 2; ++bj) {
                    const unsigned o = (unsigned)(row * DM + col0 + bj * 128);
                    const f32x4 h0 = unpk_lo(hv[cur][mm][bj]) + sigm4(acc[ai][bj][m][0] * s) * unpk_lo(pw[cur][mm][bj]), h1 = unpk_hi(hv[cur][mm][bj]) + sigm4(acc[ai][bj][m][1] * s) * unpk_hi(pw[cur][mm][bj]);
                    *(u32x4*)(hdst + o) = pack8(h0, h1);
                    ss += sumsq8(h0, h1);
                }
                ss += __shfl_xor(ss, 16); ss += __shfl_xor(ss, 32);
                if (fq == 0) part_out[(unsigned)(row * 32 + 4 * u.pn + wc)] = ss;
            }
        }
#undef PLE_LOAD
    }
};

template <int MODE>
__device__ __forceinline__ void conv_item(const float* __restrict__ W, const float* __restrict__ gain, int K, int N, bf16_t* __restrict__ WT, int kb, int nb, LAS float* scr, int lane) {
    const int k0 = kb * 64, n0 = nb * 64, cc = lane & 15, kr = lane >> 4;
    f32x4 v[16];
#pragma unroll
    for (int i = 0; i < 16; ++i) { const int kk = 4 * i + kr, n = n0 + 4 * cc;
        v[i] = (n < N) ? __builtin_nontemporal_load((const f32x4*)(W + (size_t)(k0 + kk) * N + n)) : (f32x4){0.f, 0.f, 0.f, 0.f}; }
#pragma unroll
    for (int i = 0; i < 16; ++i) { const int kk = 4 * i + kr; const float g = gain ? gain[k0 + kk] : 1.0f;
        LAS float* d = scr + kk * 65 + 4 * cc; d[0] = v[i][0] * g; d[1] = v[i][1] * g; d[2] = v[i][2] * g; d[3] = v[i][3] * g; }
    LDS_WAIT();
    const int c = lane & 7, nl = lane >> 3;
#pragma unroll
    for (int j = 0; j < 8; ++j) { const int n = nl + 8 * j; const LAS float* s = scr + (8 * c) * 65 + n;
        u32x4 o; o.x = cvt_pk_bf16(s[0], s[65]); o.y = cvt_pk_bf16(s[130], s[195]); o.z = cvt_pk_bf16(s[260], s[325]); o.w = cvt_pk_bf16(s[390], s[455]);
        const int ng = n0 + n; int row = ng;
        if (MODE == 1) { row = (ng < FF) ? (256 * (ng >> 7) + (ng & 127)) : (256 * ((ng - FF) >> 7) + 128 + ((ng - FF) & 127)); }
        *(u32x4*)(WT + (size_t)row * K + k0 + 8 * c) = o; }
    LDS_WAIT();
}


#define XB_TMO      128
#define XB_XCNT(j)  (256  + 64 * (j))
#define XB_XSUB(j)  (1280 + 64 * (j))
#define XB_XGEN(j)  (2304 + 64 * (j))
#define XB_TOP      3328
#define XB_TOPGEN   3392
#define XCD_BAR_WORDS 3456
#define XB_SPIN_CAP (1u << 22)
__device__ __forceinline__ unsigned xb_ld(unsigned* p)              { return __hip_atomic_load(p, __ATOMIC_RELAXED, __HIP_MEMORY_SCOPE_AGENT); }
__device__ __forceinline__ unsigned xb_add(unsigned* p, unsigned v) { return __hip_atomic_fetch_add(p, v, __ATOMIC_RELAXED, __HIP_MEMORY_SCOPE_AGENT); }
__device__ __forceinline__ unsigned xb_xcc_id() { return (unsigned)__builtin_amdgcn_s_getreg((3 << 11) | 20) & 0xFu; }
#define XB_SPIN(cond, bar) do { unsigned _sp = 0; while (cond) { __builtin_amdgcn_s_sleep(1); \
    if ((++_sp & 255u) == 0u) { if (xb_ld(&(bar)[XB_TMO])) break; if (_sp > XB_SPIN_CAP) { atomicAdd(&(bar)[XB_TMO], 1u); break; } } } } while (0)
__device__ __forceinline__ void xcd_barrier_complete(unsigned* bar, unsigned x, unsigned& nloc, unsigned& nx) {
    const unsigned G = gridDim.x;
    unsigned sum, cnt, mine, sp = 0u;
    for (;;) {
        sum = 0u; cnt = 0u; mine = 0u;
#pragma unroll
        for (unsigned j = 0; j < 16; ++j) { const unsigned c = xb_ld(&bar[XB_XCNT(j)]); sum += c; cnt += (c > 0u) ? 1u : 0u; mine = (j == x) ? c : mine; }
        if (sum == G) break;
        __builtin_amdgcn_s_sleep(1);
        if ((++sp & 255u) == 0u) { if (xb_ld(&bar[XB_TMO])) break; if (sp > XB_SPIN_CAP) { atomicAdd(&bar[XB_TMO], 1u); break; } }
    }
    nloc = mine > 0u ? mine : 1u; nx = cnt > 0u ? cnt : 1u;
}
__device__ __forceinline__ void xcd_barrier(unsigned* bar, volatile LAS unsigned* st) {
    asm volatile("s_waitcnt vmcnt(0)" ::: "memory");
    __syncthreads();
    if (threadIdx.x == 0) {
        const unsigned x = xb_xcc_id();
        __builtin_amdgcn_s_waitcnt(0);
        unsigned nloc = st[0], nx = st[1];
        if (nloc == 0u) { xcd_barrier_complete(bar, x, nloc, nx); st[0] = nloc; st[1] = nx; }
        const unsigned old = xb_add(&bar[XB_XSUB(x)], 1u);
        const unsigned gen = old / nloc;
        if (old + 1u == (gen + 1u) * nloc) {
            __builtin_amdgcn_fence(__ATOMIC_RELEASE, "agent");
            asm volatile("s_waitcnt vmcnt(0)" ::: "memory");
            const unsigned og = xb_add(&bar[XB_TOP], 1u);
            const unsigned tg = og / nx;
            if (og + 1u == (tg + 1u) * nx) xb_add(&bar[XB_TOPGEN], 1u);
            else XB_SPIN(xb_ld(&bar[XB_TOPGEN]) == tg, bar);
            __builtin_amdgcn_fence(__ATOMIC_ACQUIRE, "agent");
            asm volatile("s_waitcnt vmcnt(0)" ::: "memory");
        } else {
            XB_SPIN(xb_ld(&bar[XB_TOPGEN]) == gen, bar);
            __builtin_amdgcn_fence(__ATOMIC_ACQUIRE, "agent");
            asm volatile("s_waitcnt vmcnt(0)" ::: "memory");
        }
    }
    __syncthreads();
}

__device__ __forceinline__ unsigned xcd_barrier_arrive(unsigned* bar, volatile LAS unsigned* st) {
    unsigned gen = 0u;
    asm volatile("s_waitcnt vmcnt(0)" ::: "memory");
    __syncthreads();
    if (threadIdx.x == 0) {
        const unsigned x = xb_xcc_id();
        __builtin_amdgcn_s_waitcnt(0);
        unsigned nloc = st[0], nx = st[1];
        if (nloc == 0u) { xcd_barrier_complete(bar, x, nloc, nx); st[0] = nloc; st[1] = nx; }
        const unsigned old = xb_add(&bar[XB_XSUB(x)], 1u);
        gen = old / nloc;
        if (old + 1u == (gen + 1u) * nloc) {
            __builtin_amdgcn_fence(__ATOMIC_RELEASE, "agent");
            asm volatile("s_waitcnt vmcnt(0)" ::: "memory");
            const unsigned og = xb_add(&bar[XB_TOP], 1u);
            const unsigned tg = og / nx;
            if (og + 1u == (tg + 1u) * nx) xb_add(&bar[XB_TOPGEN], 1u);
        }
    }
    return gen;
}
__device__ __forceinline__ void xcd_barrier_wait(unsigned* bar, unsigned gen) {
    if (threadIdx.x == 0) {
        XB_SPIN(xb_ld(&bar[XB_TOPGEN]) == gen, bar);
        __builtin_amdgcn_fence(__ATOMIC_ACQUIRE, "agent");
        asm volatile("s_waitcnt vmcnt(0)" ::: "memory");
    }
    __syncthreads();
}

struct Args { const float* in[21]; float* out; unsigned char* ws; };
typedef const __attribute__((address_space(4))) char* kptr_t;
__device__ __forceinline__ const float* in_ptr(int i) { int off = i * 8; asm volatile("" : "+s"(off)); kptr_t kp = (kptr_t)__builtin_amdgcn_kernarg_segment_ptr(); return *(const float* const __attribute__((address_space(4)))*)(kp + off); }
__device__ __forceinline__ float* out_ptr() { return (float*)in_ptr(21); }
__device__ __forceinline__ unsigned char* ws_ptr() { return (unsigned char*)in_ptr(22); }
enum { I_X = 0, I_P, I_F1N, I_F1I, I_F1O, I_MXN, I_MXI, I_SGVG, I_SGW, I_SGB, I_GWG, I_GBG, I_GOG, I_MXO, I_F2N, I_F2I, I_F2O, I_PLN, I_PLG, I_PLP, I_FIN };

constexpr int I_1I = (DM / 64) * (NIN / 64), I_1O = (FF / 64) * (DM / 64), I_MI = (DM / 64) * (NMIXP / 64), I_MO = (DM / 64) * (DM / 64), I_PP = (DPLE / 64) * (DM / 64);
constexpr int PER_LAYER = 2 * I_1I + 2 * I_1O + I_MI + 2 * I_MO + I_PP;
constexpr int CV_PRO = I_1I;
constexpr int CV_E0 = CV_PRO + 8000;
constexpr int CV_E2 = CV_E0 + 5120;
constexpr int CV_E7 = PER_LAYER + I_1I;
constexpr int CV_E10 = CV_E7 + 8000, CV_E12 = CV_E10 + 5120, CV_E17 = 2 * PER_LAYER;
static_assert(CV_E0 >= CV_PRO + I_1O + I_MI && CV_E2 >= CV_PRO + I_1O + I_MI + I_PP + I_MO + I_1I && CV_E2 <= CV_E7 && CV_E10 >= CV_E7 + I_1O + I_MI && CV_E12 >= CV_E7 + I_1O + I_MI + I_PP + I_MO + I_1I && CV_E12 <= CV_E17, "every weight range is converted at least one barrier before its first use");
__device__ __forceinline__ void convert_items(LAS unsigned char* lds, int it0, int it1, int worker, int nworkers) {
    const int tid = opaque_tid(), lane = tid & 63, wave = __builtin_amdgcn_readfirstlane(tid >> 6);
    LAS float* scr = (LAS float*)(lds + wave * 16640);
    unsigned char* ws = ws_ptr();
    for (int it = it0 + worker * 8 + wave; it < it1; it += nworkers * 8) {
        const int l = (it >= PER_LAYER) ? 1 : 0; int r = it - l * PER_LAYER;
        unsigned char* wl = ws + (size_t)l * SZ_LAYER;
#define CONV(MODE, src, gain, K, N, NPAD, dstoff) { constexpr int nbk = (NPAD) / 64, cnt = ((K) / 64) * nbk; \
        if (r < cnt) { conv_item<MODE>((src) + (size_t)l * (K) * (N), (gain), (K), (N), (bf16_t*)(wl + (dstoff)), r / nbk, r % nbk, scr, lane); continue; } r -= cnt; }
        CONV(1, in_ptr(I_F1I), in_ptr(I_F1N) + l * DM, DM, NIN, NIN, OFF_W1I)
        CONV(0, in_ptr(I_F1O), (const float*)nullptr, FF, DM, DM, OFF_W1O)
        CONV(0, in_ptr(I_MXI), in_ptr(I_MXN) + l * DM, DM, NMIX, NMIXP, OFF_WMI)
        CONV(0, in_ptr(I_PLP), (const float*)nullptr, DPLE, DM, DM, OFF_WPP)
        CONV(0, in_ptr(I_MXO), (const float*)nullptr, DM, DM, DM, OFF_WMO)
        CONV(1, in_ptr(I_F2I), in_ptr(I_F2N) + l * DM, DM, NIN, NIN, OFF_W2I)
        CONV(0, in_ptr(I_F2O), (const float*)nullptr, FF, DM, DM, OFF_W2O)
        CONV(0, in_ptr(I_PLG), in_ptr(I_PLN) + l * DM, DM, DM, DM, OFF_WPG)
#undef CONV
    }
}
__device__ __forceinline__ void prologue(LAS unsigned char* lds, int G) {
    const int tid = opaque_tid(), lane = tid & 63, wave = __builtin_amdgcn_readfirstlane(tid >> 6);
    const int gw = blockIdx.x * 8 + wave, NGW = G * 8;
    unsigned char* ws = ws_ptr();
    bf16_t* HB = (bf16_t*)(ws + WS_HB); float* PA = (float*)(ws + WS_PARTA);
    for (int m = 2 * gw; m < MTOK; m += 2 * NGW) {
        f32x4 v[2][8]; float sq[2];
#pragma unroll
        for (int r = 0; r < 2; ++r) { const f32x4* xr = (const f32x4*)(in_ptr(I_X) + (size_t)(m + r) * DM) + lane;
#pragma unroll
            for (int j = 0; j < 8; ++j) v[r][j] = xr[64 * j]; }
#pragma unroll
        for (int r = 0; r < 2; ++r) { float t = 0.f;
#pragma unroll
            for (int j = 0; j < 8; ++j) t += (v[r][j][0] * v[r][j][0] + v[r][j][1] * v[r][j][1]) + (v[r][j][2] * v[r][j][2] + v[r][j][3] * v[r][j][3]);
            sq[r] = wave_sum(t); }
#pragma unroll
        for (int r = 0; r < 2; ++r) { u32x2* o8 = (u32x2*)(HB + (size_t)(m + r) * DM) + lane;
#pragma unroll
            for (int j = 0; j < 8; ++j) { u32x2 w; w.x = cvt_pk_bf16(v[r][j][0], v[r][j][1]); w.y = cvt_pk_bf16(v[r][j][2], v[r][j][3]); o8[64 * j] = w; }
            if (lane < 32) PA[(size_t)(m + r) * 32 + lane] = (lane == 0) ? sq[r] : 0.f; }
    }
}
__device__ __forceinline__ void prologue_p(int G) {
    const int tid = opaque_tid(), lane = tid & 63, wave = __builtin_amdgcn_readfirstlane(tid >> 6);
    const int gw = blockIdx.x * 8 + wave, NGW = G * 8;
    unsigned char* ws = ws_ptr();
    bf16_t* PB = (bf16_t*)(ws + WS_PB);
    for (int m = 4 * gw; m < 2 * MTOK; m += 4 * NGW) {
        f32x4 v[4];
#pragma unroll
        for (int r = 0; r < 4; ++r) v[r] = *((const f32x4*)(in_ptr(I_P) + (size_t)(m + r) * DPLE) + lane);
#pragma unroll
        for (int r = 0; r < 4; ++r) { u32x2 w; w.x = cvt_pk_bf16(v[r][0], v[r][1]); w.y = cvt_pk_bf16(v[r][2], v[r][3]); *((u32x2*)(PB + (size_t)(m + r) * DPLE) + lane) = w; }
    }
}

#define MFMA16(X, Y, C) __builtin_amdgcn_mfma_f32_16x16x32_bf16((X), (Y), (C), 0, 0, 0)
__device__ __forceinline__ void sg_unit(LAS unsigned char* lds, int unit, int l) {
    const int tid = opaque_tid(), lane = tid & 63, w = __builtin_amdgcn_readfirstlane(tid >> 6), fr = lane & 15, fq = lane >> 4;
    const int h = unit & 7, t0 = (unit >> 3) * 128;
    LAS bf16_t* Vt = (LAS bf16_t*)lds;
    LAS bf16_t* Wl = (LAS bf16_t*)(lds + 34816);
    LAS float* red = (LAS float*)(lds + 69632);
    const bf16_t* MX = (const bf16_t*)(ws_ptr() + WS_MX); bf16_t* YM = (bf16_t*)(ws_ptr() + WS_YM);
    const int s = tid & 127, part = tid >> 7;
    float x[32];
    {
        const u32x4* src = (const u32x4*)(MX + (size_t)(t0 + s) * MXW + 1024 + h * 128 + 32 * part);
        float sum = 0.f, sq = 0.f;
#pragma unroll
        for (int j = 0; j < 4; ++j) { const u32x4 q = src[j];
            x[8 * j + 0] = bf_lo(q.x); x[8 * j + 1] = bf_hi(q.x); x[8 * j + 2] = bf_lo(q.y); x[8 * j + 3] = bf_hi(q.y);
            x[8 * j + 4] = bf_lo(q.z); x[8 * j + 5] = bf_hi(q.z); x[8 * j + 6] = bf_lo(q.w); x[8 * j + 7] = bf_hi(q.w); }
#pragma unroll
        for (int e = 0; e < 32; ++e) { sum += x[e]; sq += x[e] * x[e]; }
        red[part * 128 + s] = sum; red[512 + part * 128 + s] = sq;
    }
    {
        const float* wsrc = in_ptr(I_SGW) + (size_t)(l * 8 + h) * 128 * 128;
#pragma unroll
        for (int j = 0; j < 8; ++j) { const int idx = tid + 512 * j, t = idx >> 5, c4 = idx & 31;
            f32x4 wv = *(const f32x4*)(wsrc + t * 128 + 4 * c4);
#pragma unroll
            for (int e = 0; e < 4; ++e) if (4 * c4 + e > t) wv[e] = 0.f;
            u32x2 o; o.x = cvt_pk_bf16(wv[0], wv[1]); o.y = cvt_pk_bf16(wv[2], wv[3]);
            *(LAS u32x2*)(Wl + t * 136 + 4 * c4) = o; }
    }
    __syncthreads();
    {
        const float sum = (red[s] + red[128 + s]) + (red[256 + s] + red[384 + s]), sq = (red[512 + s] + red[640 + s]) + (red[768 + s] + red[896 + s]);
        const float mean = sum * (1.0f / 128.0f), var = fmaxf(sq * (1.0f / 128.0f) - mean * mean, 0.f), rstd = rsqrtf(var + EPS);
        const float* gv = in_ptr(I_SGVG) + l * 1024 + h * 128 + 32 * part;
#pragma unroll
        for (int e = 0; e < 32; ++e) Vt[(32 * part + e) * 136 + s] = f2bf((x[e] - mean) * rstd * gv[e]);
    }
    __syncthreads();
    const int tq = 16 * w + fr; const float bias = in_ptr(I_SGB)[(l * 8 + h) * 128 + tq];
    const bf16_t* urow = MX + (size_t)(t0 + tq) * MXW + h * 128 + 4 * fq;
    u32x2 uuv[8];
#pragma unroll
    for (int nt = 0; nt < 8; ++nt) uuv[nt] = *(const u32x2*)(urow + 16 * nt);
    f32x4 acc[8];
#pragma unroll
    for (int nt = 0; nt < 8; ++nt) acc[nt] = (f32x4){0.f, 0.f, 0.f, 0.f};
    const int nks = (w >> 1) + 1;
    for (int ks = 0; ks < nks; ++ks) {
        const bf16x8 A = *(const LAS bf16x8*)(Wl + (16 * w + fr) * 136 + 32 * ks + 8 * fq);
#pragma unroll
        for (int nt = 0; nt < 8; ++nt) { const bf16x8 B = *(const LAS bf16x8*)(Vt + (16 * nt + fr) * 136 + 32 * ks + 8 * fq); acc[nt] = MFMA16(B, A, acc[nt]); }
    }
    {
        bf16_t* yrow = YM + (size_t)(t0 + tq) * DM + h * 128 + 4 * fq;
#pragma unroll
        for (int nt = 0; nt < 8; ++nt) { const u32x2 uu = uuv[nt];
            u32x2 o; o.x = cvt_pk_bf16(bf_lo(uu.x) * (acc[nt][0] + bias), bf_hi(uu.x) * (acc[nt][1] + bias)); o.y = cvt_pk_bf16(bf_lo(uu.y) * (acc[nt][2] + bias), bf_hi(uu.y) * (acc[nt][3] + bias));
            *(u32x2*)(yrow + 16 * nt) = o; }
    }
    __syncthreads();
}

constexpr int GL_QS = 0, GL_KS = 17408, GL_VT = 34816, GL_PS = 71680, GL_KD = 80896, GL_ZS = 99328, GL_TOT = 103424, GL_SS = 105472;
constexpr int GC = 128, NCH = SEQ / GC;
constexpr int GA_VT = 0, GA_KD = 69632, GA_ZS = 104448, GA_TOT = 112640;
constexpr int GCc_VT = 0, GCc_PS = 69632;
__device__ __forceinline__ void gla_a_unit(LAS unsigned char* lds, int unit, int l) {
    const int tid = opaque_tid(), lane = tid & 63, w = __builtin_amdgcn_readfirstlane(tid >> 6), fr = lane & 15, fq = lane >> 4;
    const int bh = unit / NCH, c = unit - bh * NCH, b = bh >> 2, h = bh & 3, t0 = b * SEQ + GC * c;
    LAS bf16_t* Vt = (LAS bf16_t*)(lds + GA_VT); LAS bf16_t* KDt = (LAS bf16_t*)(lds + GA_KD);
    LAS float* Zs = (LAS float*)(lds + GA_ZS); LAS float* TOT = (LAS float*)(lds + GA_TOT);
    const bf16_t* MX = (const bf16_t*)(ws_ptr() + WS_MX); const float* ZB = (const float*)(ws_ptr() + WS_ZB);
    *(LAS f32x4*)(Zs + tid * 4) = *(const f32x4*)(ZB + (size_t)t0 * 16 + tid * 4);
#pragma unroll
    for (int p = 0; p < 2; ++p) {
        const u32x4* src = (const u32x4*)(MX + (size_t)(t0 + 64 * p + lane) * MXW + 3072 + h * 256 + 32 * w);
#pragma unroll
        for (int j = 0; j < 4; ++j) { const u32x4 q = src[j]; LAS bf16_t* d = Vt + (32 * w + 8 * j) * 136 + 64 * p + lane;
            d[0] = (bf16_t)(q.x & 0xffff); d[136] = (bf16_t)(q.x >> 16); d[272] = (bf16_t)(q.y & 0xffff); d[408] = (bf16_t)(q.y >> 16);
            d[544] = (bf16_t)(q.z & 0xffff); d[680] = (bf16_t)(q.z >> 16); d[816] = (bf16_t)(q.w & 0xffff); d[952] = (bf16_t)(q.w >> 16); }
    }
    const int kk = tid & 127, tg = tid >> 7;
    bf16_t qraw[32], kraw[32];
    { const bf16_t* qsrc0 = MX + (size_t)(t0 + 32 * tg) * MXW + 2048 + h * 128 + kk;
#pragma unroll
      for (int i = 0; i < 32; ++i) { kraw[i] = qsrc0[(size_t)i * MXW + 512]; qraw[i] = qsrc0[(size_t)i * MXW]; } }
    float wg[16];
#pragma unroll
    for (int r = 0; r < 16; ++r) wg[r] = in_ptr(I_GWG)[(size_t)(l * 16 + r) * 512 + h * 128 + kk];
    const float bg = in_ptr(I_GBG)[l * 512 + h * 128 + kk];
    __syncthreads();
    float bl[32]; float cum = 0.f;
#pragma unroll
    for (int i = 0; i < 32; ++i) { const LAS float* z = Zs + (32 * tg + i) * 16; float g = bg;
#pragma unroll
        for (int r = 0; r < 16; ++r) g += z[r] * wg[r];
        const float ls = fminf(g, 0.f) - __logf(1.0f + __expf(-fabsf(g)));
        cum += ls * (1.0f / 16.0f); bl[i] = cum; }
    TOT[tg * 128 + kk] = cum;
    __syncthreads();
    float off = 0.f, blast = 0.f;
#pragma unroll
    for (int g = 0; g < 4; ++g) { const float t = TOT[g * 128 + kk]; blast += t; if (g < tg) off += t; }
    bf16_t* qt = (bf16_t*)(ws_ptr() + WS_QT) + (size_t)(t0 + 32 * tg) * 1024 + h * 256 + kk;
#pragma unroll
    for (int i8 = 0; i8 < 4; ++i8) {
        float kd[8];
#pragma unroll
        for (int e = 0; e < 8; ++e) { const int i = 8 * i8 + e; const float bb = bl[i] + off, kv = bf_one(kraw[i]);
            kd[e] = kv * __expf(blast - bb);
            qt[(size_t)i * 1024] = f2bf(bf_one(qraw[i]) * __expf(bb)); qt[(size_t)i * 1024 + 128] = f2bf(kv * __expf(-bb)); }
        u32x4 o; o.x = cvt_pk_bf16(kd[0], kd[1]); o.y = cvt_pk_bf16(kd[2], kd[3]); o.z = cvt_pk_bf16(kd[4], kd[5]); o.w = cvt_pk_bf16(kd[6], kd[7]);
        *(LAS u32x4*)(KDt + kk * 136 + 32 * tg + 8 * i8) = o;
    }
    if (tg == 0) ((float*)(ws_ptr() + WS_DEC))[(size_t)(bh * NCH + c) * 128 + kk] = __expf(blast);
    __syncthreads();
    f32x4 acc[2][8];
#pragma unroll
    for (int mi = 0; mi < 2; ++mi)
#pragma unroll
        for (int nt = 0; nt < 8; ++nt) acc[mi][nt] = (f32x4){0.f, 0.f, 0.f, 0.f};
#pragma unroll
    for (int ks = 0; ks < 4; ++ks) {
        const bf16x8 A0 = *(const LAS bf16x8*)(Vt + (32 * w + fr) * 136 + 32 * ks + 8 * fq), A1 = *(const LAS bf16x8*)(Vt + (32 * w + 16 + fr) * 136 + 32 * ks + 8 * fq);
#pragma unroll
        for (int nt = 0; nt < 8; ++nt) { const bf16x8 B = *(const LAS bf16x8*)(KDt + (16 * nt + fr) * 136 + 32 * ks + 8 * fq);
            acc[0][nt] = MFMA16(B, A0, acc[0][nt]); acc[1][nt] = MFMA16(B, A1, acc[1][nt]); }
    }
    float* UT = (float*)(ws_ptr() + WS_ACT) + (size_t)(bh * NCH + c) * 256 * 128;
#pragma unroll
    for (int mi = 0; mi < 2; ++mi)
#pragma unroll
        for (int nt = 0; nt < 8; ++nt) *(f32x4*)(UT + (size_t)(32 * w + 16 * mi + fr) * 128 + 16 * nt + 4 * fq) = acc[mi][nt];
    __syncthreads();
}
__device__ __forceinline__ void gla_c_unit(LAS unsigned char* lds, int unit, int l) {
    const int tid = opaque_tid(), lane = tid & 63, w = __builtin_amdgcn_readfirstlane(tid >> 6), fr = lane & 15, fq = lane >> 4;
    const int bh = unit / NCH, c = unit - bh * NCH, b = bh >> 2, h = bh & 3, t0 = b * SEQ + GC * c;
    LAS bf16_t* Vt = (LAS bf16_t*)(lds + GCc_VT); LAS bf16_t* Ps = (LAS bf16_t*)(lds + GCc_PS);
    const bf16_t* MX = (const bf16_t*)(ws_ptr() + WS_MX);
    const int i = 16 * w + fr;
    const bf16_t* QT = (const bf16_t*)(ws_ptr() + WS_QT) + (size_t)t0 * 1024 + h * 256;
    bf16x8 Aq[4];
#pragma unroll
    for (int ks = 0; ks < 4; ++ks) Aq[ks] = *(const bf16x8*)(QT + (size_t)i * 1024 + 32 * ks + 8 * fq);
#pragma unroll
    for (int p = 0; p < 2; ++p) {
        const u32x4* src = (const u32x4*)(MX + (size_t)(t0 + 64 * p + lane) * MXW + 3072 + h * 256 + 32 * w);
#pragma unroll
        for (int j = 0; j < 4; ++j) { const u32x4 q = src[j]; LAS bf16_t* d = Vt + (32 * w + 8 * j) * 136 + 64 * p + lane;
            d[0] = (bf16_t)(q.x & 0xffff); d[136] = (bf16_t)(q.x >> 16); d[272] = (bf16_t)(q.y & 0xffff); d[408] = (bf16_t)(q.y >> 16);
            d[544] = (bf16_t)(q.z & 0xffff); d[680] = (bf16_t)(q.z >> 16); d[816] = (bf16_t)(q.w & 0xffff); d[952] = (bf16_t)(q.w >> 16); }
    }
#pragma unroll
    for (int nt = 0; nt < 8; ++nt) {
        f32x4 p = (f32x4){0.f, 0.f, 0.f, 0.f};
        if (nt <= w) {
#pragma unroll
            for (int ks = 0; ks < 4; ++ks) { const bf16x8 B = *(const bf16x8*)(QT + (size_t)(16 * nt + fr) * 1024 + 128 + 32 * ks + 8 * fq); p = MFMA16(B, Aq[ks], p); }
        }
        const int j0 = 16 * nt + 4 * fq;
#pragma unroll
        for (int jj = 0; jj < 4; ++jj) if (j0 + jj > i) p[jj] = 0.f;
        u32x2 o; o.x = cvt_pk_bf16(p[0], p[1]); o.y = cvt_pk_bf16(p[2], p[3]);
        *(LAS u32x2*)(Ps + i * 136 + j0) = o;
    }
    f32x4 acc[16];
#pragma unroll
    for (int nt = 0; nt < 16; ++nt) acc[nt] = (f32x4){0.f, 0.f, 0.f, 0.f};
    const bf16_t* ST = (const bf16_t*)(ws_ptr() + WS_ST) + (size_t)(bh * NCH + c) * 256 * 128;
#pragma unroll
    for (int nt = 0; nt < 16; ++nt) { const bf16_t* srow = ST + (size_t)(16 * nt + fr) * 128 + 8 * fq;
#pragma unroll
        for (int ks = 0; ks < 4; ++ks) { const bf16x8 B = *(const bf16x8*)(srow + 32 * ks); acc[nt] = MFMA16(B, Aq[ks], acc[nt]); } }
    const float* og = in_ptr(I_GOG) + l * 1024 + h * 256 + 4 * fq;
    const bf16_t* rrow = MX + (size_t)(t0 + i) * MXW + 4096 + h * 256 + 4 * fq;
    f32x4 g4v[16]; u32x2 rrv[16];
#pragma unroll
    for (int nt = 0; nt < 16; ++nt) { g4v[nt] = *(const f32x4*)(og + 16 * nt); rrv[nt] = *(const u32x2*)(rrow + 16 * nt); }
    __syncthreads();
    const int nks = (w >> 1) + 1;
#pragma unroll
    for (int ks = 0; ks < 4; ++ks) if (ks < nks) { const bf16x8 A = *(const LAS bf16x8*)(Ps + i * 136 + 32 * ks + 8 * fq);
#pragma unroll
        for (int nt = 0; nt < 16; ++nt) { const bf16x8 B = *(const LAS bf16x8*)(Vt + (16 * nt + fr) * 136 + 32 * ks + 8 * fq); acc[nt] = MFMA16(B, A, acc[nt]); } }
    float ss = 0.f;
#pragma unroll
    for (int nt = 0; nt < 16; ++nt) ss += (acc[nt][0] * acc[nt][0] + acc[nt][1] * acc[nt][1]) + (acc[nt][2] * acc[nt][2] + acc[nt][3] * acc[nt][3]);
    ss += __shfl_xor(ss, 16); ss += __shfl_xor(ss, 32);
    const float rstd = rsqrtf(ss * (1.0f / 256.0f) + EPS);
    bf16_t* yrow = (bf16_t*)(ws_ptr() + WS_YM) + (size_t)(t0 + i) * DM + 1024 + h * 256 + 4 * fq;
#pragma unroll
    for (int nt = 0; nt < 16; ++nt) { const f32x4 g4 = g4v[nt]; const u32x2 rr = rrv[nt];
        u32x2 o; o.x = cvt_pk_bf16(acc[nt][0] * rstd * g4[0] * bf_lo(rr.x), acc[nt][1] * rstd * g4[1] * bf_hi(rr.x));
        o.y = cvt_pk_bf16(acc[nt][2] * rstd * g4[2] * bf_lo(rr.y), acc[nt][3] * rstd * g4[3] * bf_hi(rr.y));
        *(u32x2*)(yrow + 16 * nt) = o; }
    __syncthreads();
}

__device__ __forceinline__ void gla_scan(int G) {
    const float* UT = (const float*)(ws_ptr() + WS_ACT); const float* DEC = (const float*)(ws_ptr() + WS_DEC); bf16_t* ST = (bf16_t*)(ws_ptr() + WS_ST);
    for (int idx = blockIdx.x * NTHREADS + opaque_tid(); idx < 8 * 256 * 64; idx += G * NTHREADS) {
        const int e = idx * 2, kk = e & 127, dv = (e >> 7) & 255, bh = e >> 15;
        f32x2 S = (f32x2){0.f, 0.f};
        const size_t base = ((size_t)bh * NCH * 256 + dv) * 128 + kk;
#pragma unroll 8
        for (int c = 0; c < NCH; ++c) {
            const f32x2 u = *(const f32x2*)(UT + base + (size_t)c * 256 * 128);
            const f32x2 d = *(const f32x2*)(DEC + (size_t)(bh * NCH + c) * 128 + kk);
            *(unsigned*)(ST + base + (size_t)c * 256 * 128) = cvt_pk_bf16(S[0], S[1]);
            S = S * d + u;
        }
    }
}

__global__ void __launch_bounds__(NTHREADS, 2) fwd_megakernel(Args a) {
    extern __shared__ __attribute__((aligned(16))) unsigned char lds_raw[];
    LAS unsigned char* lds = (LAS unsigned char*)lds_raw;
    cg::grid_group grid = cg::this_grid();
    const int G = gridDim.x;
    volatile LAS unsigned* bst = (volatile LAS unsigned*)(lds + 134144);
    if (threadIdx.x < 2) bst[threadIdx.x] = 0u;
    __syncthreads();
    if (threadIdx.x == 0) (void)xb_add(&((unsigned*)(ws_ptr() + WS_BAR))[XB_XCNT(xb_xcc_id())], 1u);
#define GRID_BAR() xcd_barrier((unsigned*)(ws_ptr() + WS_BAR), bst)
#define WSB(off) ((bf16_t*)(ws_ptr() + (off)))
#define WSF(off) ((float*)(ws_ptr() + (off)))
    if (G == 0x7fffffff) grid.sync();
    const bool win = (G == 256);
    int probe_rep = PROBE_MIX;
    for (int st = -1; st < 20; ++st) {
        int c0 = 0, c1 = 0, cw = (int)blockIdx.x, cn = G;
        if (st < 0) { prologue(lds, G); c1 = win ? CV_PRO : 2 * PER_LAYER; }
        else {
        const int l = st / 10, k = st - 10 * l;
        if (win) {
            if (k == 0) { c0 = l ? CV_E7 : CV_PRO; c1 = l ? CV_E10 : CV_E0; cw -= 128; cn = 128; }
            else if (k == 2) { c0 = l ? CV_E10 : CV_E0; c1 = l ? CV_E12 : CV_E2; cw -= 160; cn = 96; }
            else if (k == 7) { c0 = l ? CV_E12 : CV_E2; c1 = l ? CV_E17 : CV_E7; cw -= 128; cn = 128; }
        }
        const size_t lo = (size_t)l * SZ_LAYER;
        const size_t hbo = (l & 1) ? WS_HB2 : WS_HB, hbn = (l & 1) ? WS_HB : WS_HB2;
        pg8::StaticOrder S;
        if (k == 0 || k == 7) {
            pg8::Gemm g{WSB(hbo), WSB(lo + (k == 0 ? OFF_W1I : OFF_W2I)), MTOK, NIN, DM}; S.init(MTOK, NIN, G, (int)blockIdx.x);
            pg8::Unit u0; const bool has0 = S.next(0, u0); LAS float* tab = (LAS float*)(lds + RSTD_OFF);
            EpiSwiglu E{WSB(WS_ACT), WSF(WS_PARTA), tab, has0 ? u0.pm : -1};
            pg8::gemm_phase(lds, g, S, E, TabPre{tab, WSF(WS_PARTA), u0.pm});
        } else if (k == 1 || k == 6 || k == 8) {
            pg8::Gemm g{(k == 6) ? WSB(WS_YM) : WSB(WS_ACT), WSB(lo + (k == 1 ? OFF_W1O : (k == 6 ? OFF_WMO : OFF_W2O))), MTOK, DM, (k == 6) ? DM : FF}; S.init(MTOK, DM, G, (int)blockIdx.x);
            EpiResid E{WSB(hbo), (k == 6) ? WSF(WS_PARTA) : WSF(WS_PARTB), (k == 6) ? 1.0f : 0.5f};
            pg8::gemm_phase(lds, g, S, E, pg8::NoPre{}, true);
        } else if (k == 2) {
            { pg8::Gemm g{WSB(hbo), WSB(lo + OFF_WMI), MTOK, NMIXP, DM}; S.init(MTOK, NMIXP, G, (int)blockIdx.x);
              pg8::Unit u0; const bool has0 = S.next(0, u0); LAS float* tab = (LAS float*)(lds + RSTD_OFF);
              EpiMixIn E{WSB(WS_MX), WSF(WS_ZB), WSF(WS_PARTB), tab, has0 ? u0.pm : -1};
              pg8::gemm_phase(lds, g, S, E, TabPre{tab, WSF(WS_PARTB), u0.pm}); }
        } else if (k == 3 || k == 4) {
            if (k == 3) { for (int u = blockIdx.x; u < 8 * NCH; u += G) gla_a_unit(lds, u, l); } else gla_scan(G);
            const unsigned bgen = xcd_barrier_arrive((unsigned*)(ws_ptr() + WS_BAR), bst);
            for (int u = (k == 3 ? 0 : 256) + (int)blockIdx.x; u < (k == 3 ? 256 : 512); u += G) sg_unit(lds, u, l);
            xcd_barrier_wait((unsigned*)(ws_ptr() + WS_BAR), bgen);
            continue;
        } else if (k == 5) {
            for (int u = blockIdx.x; u < 8 * NCH; u += G) gla_c_unit(lds, u, l);
            {
                const unsigned bgen = xcd_barrier_arrive((unsigned*)(ws_ptr() + WS_BAR), bst);
                pg8::Gemm g{WSB(WS_PB) + (size_t)l * MTOK * DPLE, WSB(lo + OFF_WPP), MTOK, DM, DPLE}; S.init(MTOK, DM, G, (int)blockIdx.x);
                EpiStore E{WSB(WS_PP)};
                pg8::gemm_phase(lds, g, S, E, pg8::NoPre{});
                xcd_barrier_wait((unsigned*)(ws_ptr() + WS_BAR), bgen);
                continue;
            }
        } else {
            pg8::Gemm g{WSB(hbo), WSB(lo + OFF_WPG), MTOK, DM, DM}; S.init(MTOK, DM, G, (int)blockIdx.x);
            pg8::Unit u0; const bool has0 = S.next(0, u0); LAS float* tab = (LAS float*)(lds + RSTD_OFF);
            EpiPle E{WSB(hbo), WSB(hbn), WSB(WS_PP), WSF(WS_PARTB), WSF(WS_PARTA), tab, has0 ? u0.pm : -1};
            pg8::gemm_phase(lds, g, S, E, TabPre{tab, WSF(WS_PARTB), u0.pm});
        }
        }
        if (cw >= 0 && c0 < c1) convert_items(lds, c0, c1, cw, cn);
        if (st < 0) { const unsigned bgen = xcd_barrier_arrive((unsigned*)(ws_ptr() + WS_BAR), bst); prologue_p(G); xcd_barrier_wait((unsigned*)(ws_ptr() + WS_BAR), bgen); continue; }
        GRID_BAR();
    }
    {
        const int tid = opaque_tid(), lane = tid & 63, wave = tid >> 6, gw = blockIdx.x * 8 + wave, NGW = G * 8;
        const f32x4* gf = (const f32x4*)in_ptr(I_FIN) + 2 * lane;
        for (int m = 2 * gw; m < MTOK; m += 2 * NGW) {
            float ps[2]; u32x4 w[2][4];
#pragma unroll
            for (int r = 0; r < 2; ++r) { ps[r] = (lane < 32) ? WSF(WS_PARTA)[(size_t)(m + r) * 32 + lane] : 0.f;
                const u32x4* hrow = (const u32x4*)(WSB(WS_HB) + (size_t)(m + r) * DM) + lane;
#pragma unroll
                for (int j = 0; j < 4; ++j) w[r][j] = hrow[64 * j]; }
#pragma unroll
            for (int r = 0; r < 2; ++r) { const float rstd = rsqrtf(wave_sum(ps[r]) * (1.0f / DM) + EPS);
                f32x4* orow = (f32x4*)(out_ptr() + (size_t)(m + r) * DM) + 2 * lane;
#pragma unroll
                for (int j = 0; j < 4; ++j) { orow[128 * j] = unpk_lo(w[r][j]) * rstd * gf[128 * j]; orow[128 * j + 1] = unpk_hi(w[r][j]) * rstd * gf[128 * j + 1]; } }
        }
    }
}

extern "C" void kernel_launch(void* const* d_in, const int* in_sizes, int n_in, void* d_out, int out_size, void* d_ws, size_t ws_size, hipStream_t stream) {
    static int grid = 0;
    if (grid == 0) {
        if (n_in != 21 || out_size != MTOK * DM || ws_size < WS_END) { fprintf(stderr, "kernel_launch: unexpected shapes (n_in %d, out %d, ws %zu < %zu)\n", n_in, out_size, ws_size, (size_t)WS_END); grid = -1; return; }
        int dev = 0, cus = 0, per_cu = 0;
        hipGetDevice(&dev);
        hipDeviceGetAttribute(&cus, hipDeviceAttributeMultiprocessorCount, dev);
        hipFuncSetAttribute((const void*)fwd_megakernel, hipFuncAttributeMaxDynamicSharedMemorySize, LDS_BYTES);
        hipOccupancyMaxActiveBlocksPerMultiprocessor(&per_cu, (const void*)fwd_megakernel, NTHREADS, LDS_BYTES);
        if (per_cu < 1) { fprintf(stderr, "kernel_launch: occupancy query says %d blocks per CU\n", per_cu); per_cu = 1; }
        grid = cus * per_cu;
        (void)hipGetLastError();
    }
    if (grid < 0) return;
    if (hipMemsetAsync((char*)d_ws + WS_BAR, 0, BAR_BYTES, stream) != hipSuccess) { fprintf(stderr, "kernel_launch: memset of barrier words failed\n"); return; }
    Args a{};
    for (int i = 0; i < 21; ++i) a.in[i] = (const float*)d_in[i];
    a.out = (float*)d_out; a.ws = (unsigned char*)d_ws;
    void* args[] = {&a};
    hipError_t e = hipLaunchCooperativeKernel((const void*)fwd_megakernel, dim3(grid), dim3(NTHREADS), args, LDS_BYTES, stream);
    if (e != hipSuccess) fprintf(stderr, "cooperative launch failed: %s (grid %d)\n", hipGetErrorString(e), grid);
}
```

```cpp
#include <hip/hip_runtime.h>
#include <hip/hip_cooperative_groups.h>
#include <cstdio>
#include <cstdint>
namespace cg = cooperative_groups;
#ifndef PROBE_SYNCS
#define PROBE_SYNCS 0
#endif
#ifndef PROBE_PRO
#define PROBE_PRO 0
#endif
#ifndef PROBE_MIX
#define PROBE_MIX 0
#endif
#ifndef PROBE_FFNIN
#define PROBE_FFNIN 0
#endif

#define LAS __attribute__((address_space(3)))
typedef unsigned short bf16_t;
typedef short bf16x8 __attribute__((ext_vector_type(8)));
typedef float f32x4 __attribute__((ext_vector_type(4)));
typedef float f32x2 __attribute__((ext_vector_type(2)));
typedef unsigned u32x4 __attribute__((ext_vector_type(4)));
typedef unsigned u32x2 __attribute__((ext_vector_type(2)));

constexpr int MTOK = 8192, DM = 2048, FF = 5632, NIN = 2 * FF, NMIX = 5136, NMIXP = 5376, MXW = 5120, DPLE = 256, SEQ = 4096;
constexpr float EPS = 1e-6f;
constexpr int NTHREADS = 512;
constexpr int LDS_BYTES = 137216;
constexpr int RSTD_OFF = 135168;

constexpr size_t SZ_W1I = (size_t)NIN * DM * 2, SZ_W1O = (size_t)DM * FF * 2, SZ_WMI = (size_t)NMIXP * DM * 2, SZ_WMO = (size_t)DM * DM * 2, SZ_WPG = (size_t)DM * DM * 2, SZ_WPP = (size_t)DM * DPLE * 2;
constexpr size_t OFF_W1I = 0, OFF_W1O = OFF_W1I + SZ_W1I, OFF_WMI = OFF_W1O + SZ_W1O, OFF_WMO = OFF_WMI + SZ_WMI, OFF_W2I = OFF_WMO + SZ_WMO, OFF_W2O = OFF_W2I + SZ_W1I,
                 OFF_WPG = OFF_W2O + SZ_W1O, OFF_WPP = OFF_WPG + SZ_WPG, SZ_LAYER = OFF_WPP + SZ_WPP;
constexpr size_t WS_HB = 2 * SZ_LAYER;
constexpr size_t WS_ACT = WS_HB + (size_t)MTOK * DM * 2;
constexpr size_t WS_MX = WS_ACT + (size_t)MTOK * FF * 2;
constexpr size_t WS_ZB = WS_MX + (size_t)MTOK * MXW * 2;
constexpr size_t WS_YM = WS_ZB + (size_t)MTOK * 16 * 4;
constexpr size_t WS_PP = WS_YM + (size_t)MTOK * DM * 2;
constexpr size_t WS_PB = WS_PP + (size_t)MTOK * DM * 2;
constexpr size_t WS_PARTA = WS_PB + (size_t)2 * MTOK * DPLE * 2;
constexpr size_t WS_PARTB = WS_PARTA + (size_t)MTOK * 32 * 4;
constexpr size_t WS_ST = WS_PARTB + (size_t)MTOK * 32 * 4;
constexpr size_t WS_DEC = WS_ST + (size_t)8 * 64 * 256 * 128 * 2;
constexpr size_t WS_HB2 = WS_DEC + (size_t)8 * 64 * 128 * 4;
constexpr size_t WS_QT = WS_HB2 + (size_t)MTOK * DM * 2;
constexpr size_t WS_BAR = WS_QT + (size_t)MTOK * 1024 * 2;
constexpr size_t BAR_BYTES = 16384;
constexpr size_t WS_END = WS_BAR + BAR_BYTES;
static_assert((size_t)8 * 64 * 256 * 128 * 4 <= (size_t)MTOK * FF * 2, "UT fits in ACT");

#define LDS_WAIT() asm volatile("s_waitcnt lgkmcnt(0)" ::: "memory")
__device__ __forceinline__ unsigned cvt_pk_bf16(float lo, float hi) { unsigned r; asm volatile("v_cvt_pk_bf16_f32 %0, %1, %2" : "=v"(r) : "v"(lo), "v"(hi)); return r; }
__device__ __forceinline__ float bf_lo(unsigned w) { return __uint_as_float(w << 16); }
__device__ __forceinline__ float bf_hi(unsigned w) { return __uint_as_float(w & 0xffff0000u); }
__device__ __forceinline__ float bf_one(bf16_t h) { return __uint_as_float(((unsigned)h) << 16); }
__device__ __forceinline__ bf16_t f2bf(float f) { return (bf16_t)(cvt_pk_bf16(f, 0.f) & 0xffffu); }
__device__ __forceinline__ float sigmoidf_(float x) { return __builtin_amdgcn_rcpf(1.0f + __expf(-x)); }
__device__ __forceinline__ float siluf_(float x) { return x * sigmoidf_(x); }
__device__ __forceinline__ int opaque_tid() { int t = threadIdx.x; asm volatile("" : "+v"(t)); return t; }
__device__ __forceinline__ float wave_sum(float v) {
#pragma unroll
    for (int o = 1; o < 64; o <<= 1) v += __shfl_xor(v, o);
    return v;
}
__device__ __forceinline__ f32x2 gelu_pk(f32x2 v) {
    const f32x2 av = __builtin_elementwise_abs(v), d = av * 0.2316418882f + 1.0f;
    f32x2 t; t.x = __builtin_amdgcn_rcpf(d.x); t.y = __builtin_amdgcn_rcpf(d.y);
    f32x2 q = t * 0.5307027145f + (-0.7265760135f); q = q * t + 0.7107068705f; q = q * t + (-0.142248368f); q = q * t + 0.127414796f; q = q * t;
    const f32x2 s = (v * v) * (-0.72134752044f);
    f32x2 e; e.x = __builtin_amdgcn_exp2f(s.x); e.y = __builtin_amdgcn_exp2f(s.y);
    const f32x2 m = v * (q * e), r = v - m;
    f32x2 o; o.x = v.x < 0.f ? m.x : r.x; o.y = v.y < 0.f ? m.y : r.y; return o;
}
__device__ __forceinline__ f32x4 gelu4(f32x4 v) { f32x2 a = gelu_pk((f32x2){v[0], v[1]}), b = gelu_pk((f32x2){v[2], v[3]}); return (f32x4){a.x, a.y, b.x, b.y}; }
__device__ __forceinline__ f32x4 silu4(f32x4 v) { return (f32x4){siluf_(v[0]), siluf_(v[1]), siluf_(v[2]), siluf_(v[3])}; }
__device__ __forceinline__ f32x4 sigm4(f32x4 v) { return (f32x4){sigmoidf_(v[0]), sigmoidf_(v[1]), sigmoidf_(v[2]), sigmoidf_(v[3])}; }
__device__ __forceinline__ u32x4 pack8(f32x4 a, f32x4 b) { u32x4 w; w.x = cvt_pk_bf16(a[0], a[1]); w.y = cvt_pk_bf16(a[2], a[3]); w.z = cvt_pk_bf16(b[0], b[1]); w.w = cvt_pk_bf16(b[2], b[3]); return w; }
__device__ __forceinline__ float row_rstd(const float* part, int row, int fq) {
    const f32x4* p = (const f32x4*)(part + (size_t)row * 32 + 8 * fq);
    const f32x4 a = p[0], b = p[1];
    float s = ((a[0] + a[1]) + (a[2] + a[3])) + ((b[0] + b[1]) + (b[2] + b[3]));
    s += __shfl_xor(s, 16); s += __shfl_xor(s, 32);
    return rsqrtf(s * (1.0f / DM) + EPS);
}

namespace pg8 {
constexpr int BM = 256, BK = 64, HALF = 128, HTB = HALF * BK * 2, STAGE_BYTES = 8 * HTB, NXCD = 8, WGM = 4;
__host__ __device__ __forceinline__ int lds_byte(int r, int c) { const int st = (r >> 4) * 2 + (c >> 5), rr = r & 15, cc = c & 31, ob = rr * 64 + cc * 2; return st * 1024 + (ob ^ (((ob >> 9) & 1) << 5)); }
__host__ __device__ __forceinline__ void stage_rc(int b, int& R, int& C) { const int st = b / 1024, sb = b % 1024, swz = sb ^ (((sb >> 9) & 1) << 5); R = (st >> 1) * 16 + swz / 64; C = (st & 1) * 32 + (swz % 64) / 2; }
__host__ __device__ __forceinline__ int perm32(int rho) { const int n = rho >> 4, i = rho & 15; return 8 * (i >> 2) + 4 * n + (i & 3); }
struct Unit { int pm, pn; };
struct Gemm { const bf16_t* A; const bf16_t* Bt; int M, N, K; };
struct StaticOrder {
    int nM, nN, nwg, G, c;
    __device__ void init(int M, int N, int G_, int c_) { nM = M / BM; nN = N / BM; nwg = nM * nN; G = G_; c = c_; }
    __device__ bool next(int i, Unit& u) const {
        const long L = (long)i * G + c; if (L >= nwg) return false;
        int wgid = (int)L; { const int q = nwg / NXCD, r = nwg % NXCD, xcd = wgid % NXCD, off = wgid / NXCD; wgid = (xcd < r ? xcd * (q + 1) : r * (q + 1) + (xcd - r) * q) + off; }
        const int nig = WGM * nN, gid = wgid / nig, fm = gid * WGM, gsz = (nM - fm) < WGM ? (nM - fm) : WGM;
        u.pm = fm + ((wgid % nig) % gsz); u.pn = (wgid % nig) / gsz; return true;
    }
};
struct NoPre { __device__ __forceinline__ void operator()() const {} };
template <class Epi, class Pre>
__device__ __forceinline__ void gemm_phase(LAS unsigned char* lds, const Gemm g, const StaticOrder& S, const Epi& E, const Pre& pre, const bool rev0 = false) {
    const int tid = opaque_tid(), wid = __builtin_amdgcn_readfirstlane(tid >> 6), lane = tid & 63, wr = wid >> 2, wc = wid & 3, fr = lane & 15, fq = lane >> 4;
    int K = g.K; asm volatile("" : "+s"(K)); const int nt = K / BK;
    unsigned voffA[2], voffB[2];
#pragma unroll
    for (int i = 0; i < 2; ++i) { int R, C; stage_rc(tid * 16 + i * 8192, R, C); const int Rb = (R & ~31) + perm32(R & 31);
        voffA[i] = (unsigned)(R * K + C) * 2u; voffB[i] = (unsigned)(Rb * K + C) * 2u; }
    const unsigned kstep = (unsigned)(BK * 2);
    const unsigned hstep = (unsigned)(HALF * 2) * (unsigned)K;
    const unsigned tstep = 2u * hstep;
    const __amdgpu_buffer_rsrc_t rA = __builtin_amdgcn_make_buffer_rsrc((void*)g.A, 0, 0x7ffffffc, 0x00020000), rB = __builtin_amdgcn_make_buffer_rsrc((void*)g.Bt, 0, 0x7ffffffc, 0x00020000);
    const unsigned ldsw = (unsigned)wid * 1024u;
    const int aoff = lds_byte(wr * 64 + fr, fq * 8), boff = lds_byte(wc * 32 + fr, fq * 8);
#define PG8_SA(b, h) (((b) * 2 + (h)) * HTB)
#define PG8_SB(b, h) ((4 + (b) * 2 + (h)) * HTB)
#define PG8_STAGE(bufoff, rsrc, soff, voff) do { const unsigned _so = (soff); _Pragma("unroll") for (int _i = 0; _i < 2; ++_i) \
        __builtin_amdgcn_raw_ptr_buffer_load_lds((rsrc), (LAS void*)(lds + (bufoff) + ldsw + _i * 8192), 16, (voff)[_i], _so, 0, 0); } while (0)
#define PG8_LDA(dst, b, h) do { _Pragma("unroll") for (int m = 0; m < 4; ++m) _Pragma("unroll") for (int k = 0; k < 2; ++k) dst[m][k] = *(const LAS bf16x8*)(lds + PG8_SA(b, h) + aoff + m * 2048 + k * 1024); } while (0)
#define PG8_LDB(dst, b, h) do { _Pragma("unroll") for (int n = 0; n < 2; ++n) _Pragma("unroll") for (int k = 0; k < 2; ++k) dst[n][k] = *(const LAS bf16x8*)(lds + PG8_SB(b, h) + boff + n * 2048 + k * 1024); } while (0)
#define PG8_MMA(ai, bj, At, Bt) do { __builtin_amdgcn_s_setprio(1); _Pragma("unroll") for (int m = 0; m < 4; ++m) _Pragma("unroll") for (int n = 0; n < 2; ++n) _Pragma("unroll") for (int k = 0; k < 2; ++k) \
        acc[ai][bj][m][n] = __builtin_amdgcn_mfma_f32_16x16x32_bf16(Bt[n][k], At[m][k], acc[ai][bj][m][n], 0, 0, 0); __builtin_amdgcn_s_setprio(0); } while (0)
#define PG8_WAIT_V(n) asm volatile("s_waitcnt vmcnt(" #n ")" ::: "memory")
#define PG8_WAIT_L(n) asm volatile("s_waitcnt lgkmcnt(" #n ")" ::: "memory")
#define PG8_BAR __builtin_amdgcn_s_barrier()
#define PG8_SCHED __builtin_amdgcn_sched_barrier(0)
    Unit cur, nxt; int ui = 0;
    if (!S.next(0, cur)) return;
    f32x4 acc[2][2][4][2];
#pragma unroll
    for (int a = 0; a < 2; ++a)
#pragma unroll
        for (int b = 0; b < 2; ++b)
#pragma unroll
            for (int m = 0; m < 4; ++m)
#pragma unroll
                for (int n = 0; n < 2; ++n) acc[a][b][m][n] = (f32x4){0.f, 0.f, 0.f, 0.f};
    bf16x8 At[4][2], B0[2][2], B1[2][2];
    unsigned ks = rev0 ? (0u - kstep) : kstep; const unsigned rv0 = rev0 ? (unsigned)(nt - 1) * kstep : 0u;
    unsigned oA = (unsigned)cur.pm * tstep + rv0, oB = (unsigned)cur.pn * tstep + rv0;

    PG8_STAGE(PG8_SB(0, 0), rB, oB, voffB); PG8_STAGE(PG8_SB(0, 1), rB, oB + hstep, voffB); PG8_STAGE(PG8_SA(0, 0), rA, oA, voffA); PG8_STAGE(PG8_SA(0, 1), rA, oA + hstep, voffA);
    pre();
    if (wr == 1) PG8_BAR;
    PG8_WAIT_V(2); PG8_BAR;
    PG8_STAGE(PG8_SB(1, 0), rB, oB + ks, voffB); PG8_STAGE(PG8_SA(1, 0), rA, oA + ks, voffA); PG8_STAGE(PG8_SB(1, 1), rB, oB + hstep + ks, voffB);
    PG8_WAIT_V(6); PG8_BAR;
    for (;;) {
        const bool has_next = S.next(ui + 1, nxt);
        const unsigned nks = has_next ? (0u - ks) : ks, nrev = (nks != kstep) ? (unsigned)(nt - 1) * kstep : 0u;
        const unsigned noA = has_next ? (unsigned)nxt.pm * tstep + nrev : oA, noB = has_next ? (unsigned)nxt.pn * tstep + nrev : oB;
        for (int t = 0; t < nt; t += 2) {
            const bool last = (t == nt - 2);
            const unsigned tk = (unsigned)t * ks;
            const unsigned a1 = oA + tk + ks;
            const unsigned a2 = last ? noA : oA + tk + 2u * ks, b2 = last ? noB : oB + tk + 2u * ks;
            const unsigned a3 = a2 + (last ? nks : ks), b3 = b2 + (last ? nks : ks);
            PG8_LDB(B0, 0, 0); PG8_LDB(B1, 0, 1); PG8_SCHED; PG8_LDA(At, 0, 0); PG8_STAGE(PG8_SA(1, 1), rA, a1 + hstep, voffA);
            PG8_WAIT_V(8); PG8_WAIT_L(0); PG8_BAR; PG8_MMA(0, 0, At, B0); PG8_MMA(0, 1, At, B1); PG8_BAR; PG8_SCHED;
            PG8_LDA(At, 0, 1); PG8_STAGE(PG8_SB(0, 0), rB, b2, voffB); PG8_STAGE(PG8_SB(0, 1), rB, b2 + hstep, voffB); PG8_STAGE(PG8_SA(0, 0), rA, a2, voffA);
            PG8_WAIT_V(8); PG8_WAIT_L(0); PG8_BAR; PG8_MMA(1, 0, At, B0); PG8_MMA(1, 1, At, B1); PG8_BAR; PG8_SCHED;
            PG8_LDB(B0, 1, 0); PG8_LDB(B1, 1, 1); PG8_SCHED; PG8_LDA(At, 1, 0); PG8_STAGE(PG8_SA(0, 1), rA, a2 + hstep, voffA);
            PG8_WAIT_V(8); PG8_WAIT_L(0); PG8_BAR; PG8_MMA(0, 0, At, B0); PG8_MMA(0, 1, At, B1); PG8_BAR; PG8_SCHED;
            PG8_LDA(At, 1, 1); PG8_STAGE(PG8_SB(1, 0), rB, b3, voffB); PG8_STAGE(PG8_SB(1, 1), rB, b3 + hstep, voffB); PG8_STAGE(PG8_SA(1, 0), rA, a3, voffA);
            PG8_WAIT_V(8); PG8_WAIT_L(0); PG8_BAR; PG8_MMA(1, 0, At, B0); PG8_MMA(1, 1, At, B1); PG8_BAR; PG8_SCHED;
        }
        if (wr == 0) PG8_BAR;
        E(acc, cur, wr, wc, fr, fq);
        if (!has_next) break;
#pragma unroll
        for (int a = 0; a < 2; ++a)
#pragma unroll
            for (int b = 0; b < 2; ++b)
#pragma unroll
                for (int m = 0; m < 4; ++m)
#pragma unroll
                    for (int n = 0; n < 2; ++n) acc[a][b][m][n] = (f32x4){0.f, 0.f, 0.f, 0.f};
        cur = nxt; oA = noA; oB = noB; ks = nks; ++ui;
        if (wr == 1) PG8_BAR;
    }
    PG8_WAIT_V(0);
    PG8_BAR;
#undef PG8_SA
#undef PG8_SB
#undef PG8_STAGE
#undef PG8_LDA
#undef PG8_LDB
#undef PG8_MMA
#undef PG8_WAIT_V
#undef PG8_WAIT_L
#undef PG8_BAR
#undef PG8_SCHED
}
}
using pg8::Unit;
typedef f32x4 AccT[2][2][4][2];

__device__ __forceinline__ void row_rstd8(const float* part, int row0, int fq, float (&rs)[2][4]) {
#pragma unroll
    for (int ai = 0; ai < 2; ++ai) {
        f32x4 pa[4], pb[4];
#pragma unroll
        for (int m = 0; m < 4; ++m) { const f32x4* p = (const f32x4*)(part + (unsigned)((row0 + ai * 128 + m * 16) * 32 + 8 * fq)); pa[m] = p[0]; pb[m] = p[1]; }
#pragma unroll
        for (int m = 0; m < 4; ++m) { const f32x4 a = pa[m], b = pb[m];
            float s = ((a[0] + a[1]) + (a[2] + a[3])) + ((b[0] + b[1]) + (b[2] + b[3]));
            s += __shfl_xor(s, 16); s += __shfl_xor(s, 32);
            rs[ai][m] = rsqrtf(s * (1.0f / DM) + EPS); }
    }
}
__device__ __forceinline__ void fill_rstd_table(LAS float* tab, const float* part, int pm) {
    const int tid = opaque_tid(), row = tid >> 1, half = tid & 1;
    const f32x4* p = (const f32x4*)(part + (unsigned)((pm * 256 + row) * 32 + 16 * half));
    const f32x4 a = p[0], b = p[1], c = p[2], d = p[3];
    float s = (((a[0] + a[1]) + (a[2] + a[3])) + ((b[0] + b[1]) + (b[2] + b[3]))) + (((c[0] + c[1]) + (c[2] + c[3])) + ((d[0] + d[1]) + (d[2] + d[3])));
    s += __shfl_xor(s, 1);
    if (half == 0) tab[row] = rsqrtf(s * (1.0f / DM) + EPS);
    __syncthreads();
}
struct TabPre {
    LAS float* tab; const float* part; int pm;
    __device__ __forceinline__ void operator()() const {
        const int tid = opaque_tid(), row = tid >> 1, half = tid & 1;
        const f32x4* p = (const f32x4*)(part + (unsigned)((pm * 256 + row) * 32 + 16 * half));
        const f32x4 a = p[0], b = p[1], c = p[2], d = p[3];
        float s = (((a[0] + a[1]) + (a[2] + a[3])) + ((b[0] + b[1]) + (b[2] + b[3]))) + (((c[0] + c[1]) + (c[2] + c[3])) + ((d[0] + d[1]) + (d[2] + d[3])));
        s += __shfl_xor(s, 1);
        if (half == 0) tab[row] = rsqrtf(s * (1.0f / DM) + EPS);
    }
};
__device__ __forceinline__ void row_scales(const float* part, const LAS float* tab, int pm0, int pm, int row0, int wr, int fr, int fq, float (&rs)[2][4]) {
    if (pm == pm0) {
#pragma unroll
        for (int ai = 0; ai < 2; ++ai)
#pragma unroll
            for (int m = 0; m < 4; ++m) rs[ai][m] = tab[ai * 128 + wr * 64 + m * 16 + fr];
    } else row_rstd8(part, row0, fq, rs);
}
__device__ __forceinline__ float sumsq8(f32x4 h0, f32x4 h1) { return ((h0[0] * h0[0] + h0[1] * h0[1]) + (h0[2] * h0[2] + h0[3] * h0[3])) + ((h1[0] * h1[0] + h1[1] * h1[1]) + (h1[2] * h1[2] + h1[3] * h1[3])); }
struct EpiSwiglu {
    bf16_t* act; const float* part; const LAS float* tab; int pm0;
    __device__ __forceinline__ void operator()(const AccT& acc, const Unit& u, int wr, int wc, int fr, int fq) const {
        const int row0 = u.pm * 256 + wr * 64 + fr, col0 = u.pn * 128 + wc * 32 + 8 * fq;
        float rs[2][4]; row_scales(part, tab, pm0, u.pm, row0, wr, fr, fq, rs);
#pragma unroll
        for (int ai = 0; ai < 2; ++ai)
#pragma unroll
            for (int m = 0; m < 4; ++m) {
                const int row = row0 + ai * 128 + m * 16; const float s = rs[ai][m], sl = s * -1.4426950408889634f, s2 = s * s;
                const f32x4 g0 = acc[ai][0][m][0], g1 = acc[ai][0][m][1];
                const f32x4 a0 = g0 * sl, a1 = g1 * sl;
                const f32x4 e0 = (f32x4){__builtin_amdgcn_exp2f(a0[0]), __builtin_amdgcn_exp2f(a0[1]), __builtin_amdgcn_exp2f(a0[2]), __builtin_amdgcn_exp2f(a0[3])} + 1.0f;
                const f32x4 e1 = (f32x4){__builtin_amdgcn_exp2f(a1[0]), __builtin_amdgcn_exp2f(a1[1]), __builtin_amdgcn_exp2f(a1[2]), __builtin_amdgcn_exp2f(a1[3])} + 1.0f;
                const f32x4 r0 = (f32x4){__builtin_amdgcn_rcpf(e0[0]), __builtin_amdgcn_rcpf(e0[1]), __builtin_amdgcn_rcpf(e0[2]), __builtin_amdgcn_rcpf(e0[3])};
                const f32x4 r1 = (f32x4){__builtin_amdgcn_rcpf(e1[0]), __builtin_amdgcn_rcpf(e1[1]), __builtin_amdgcn_rcpf(e1[2]), __builtin_amdgcn_rcpf(e1[3])};
                *(u32x4*)(act + (unsigned)(row * FF + col0)) = pack8((g0 * acc[ai][1][m][0]) * s2 * r0, (g1 * acc[ai][1][m][1]) * s2 * r1);
            }
    }
};
__device__ __forceinline__ f32x4 unpk_lo(u32x4 w) { return (f32x4){bf_lo(w.x), bf_hi(w.x), bf_lo(w.y), bf_hi(w.y)}; }
__device__ __forceinline__ f32x4 unpk_hi(u32x4 w) { return (f32x4){bf_lo(w.z), bf_hi(w.z), bf_lo(w.w), bf_hi(w.w)}; }
struct EpiResid {
    bf16_t* hb; float* part; float scale;
    __device__ __forceinline__ void operator()(const AccT& acc, const Unit& u, int wr, int wc, int fr, int fq) const {
        const int row0 = u.pm * 256 + wr * 64 + fr, col0 = u.pn * 256 + wc * 32 + 8 * fq;
        u32x4 hv[2][4][2];
#pragma unroll
        for (int ai = 0; ai < 2; ++ai)
#pragma unroll
            for (int m = 0; m < 4; ++m)
#pragma unroll
                for (int bj = 0; bj < 2; ++bj) hv[ai][m][bj] = *(const u32x4*)(hb + (unsigned)((row0 + ai * 128 + m * 16) * DM + col0 + bj * 128));
#pragma unroll
        for (int ai = 0; ai < 2; ++ai) {
#pragma unroll
            for (int m = 0; m < 4; ++m) {
                const int row = row0 + ai * 128 + m * 16; float ss = 0.f;
#pragma unroll
                for (int bj = 0; bj < 2; ++bj) {
                    const unsigned o = (unsigned)(row * DM + col0 + bj * 128);
                    const f32x4 h0 = unpk_lo(hv[ai][m][bj]) + acc[ai][bj][m][0] * scale, h1 = unpk_hi(hv[ai][m][bj]) + acc[ai][bj][m][1] * scale;
                    *(u32x4*)(hb + o) = pack8(h0, h1);
                    ss += sumsq8(h0, h1);
                }
                ss += __shfl_xor(ss, 16); ss += __shfl_xor(ss, 32);
                if (fq == 0) part[(unsigned)(row * 32 + 4 * u.pn + wc)] = ss;
            }
        }
    }
};
struct EpiMixIn {
    bf16_t* mx; float* zb; const float* part; const LAS float* tab; int pm0;
    __device__ __forceinline__ void operator()(const AccT& acc, const Unit& u, int wr, int wc, int fr, int fq) const {
        const int row0 = u.pm * 256 + wr * 64 + fr, pn = u.pn, col0 = pn * 256 + wc * 32 + 8 * fq;
        float rs[2][4]; row_scales(part, tab, pm0, u.pm, row0, wr, fr, fq, rs);
#pragma unroll
        for (int ai = 0; ai < 2; ++ai)
#pragma unroll
            for (int m = 0; m < 4; ++m) {
                const int row = row0 + ai * 128 + m * 16; const float s = rs[ai][m];
#pragma unroll
                for (int bj = 0; bj < 2; ++bj) {
                    f32x4 v0 = acc[ai][bj][m][0] * s, v1 = acc[ai][bj][m][1] * s;
                    if (pn < 8) { v0 = gelu4(v0); v1 = gelu4(v1); }
                    else if (pn < 10) { v0 = v0 * 0.08838834764831845f; v1 = v1 * 0.08838834764831845f; }
                    else if (pn >= 16 && pn < 20) { v0 = silu4(v0); v1 = silu4(v1); }
                    if (pn < 20) *(u32x4*)(mx + (unsigned)(row * MXW + col0 + bj * 128)) = pack8(v0, v1);
                    else if (bj == 0 && wc == 0 && fq < 2) { float* z = zb + (unsigned)(row * 16 + 8 * fq); *(f32x4*)z = v0; *(f32x4*)(z + 4) = v1; }
                }
            }
    }
};
struct EpiStore {
    bf16_t* o;
    __device__ __forceinline__ void operator()(const AccT& acc, const Unit& u, int wr, int wc, int fr, int fq) const {
        const int row0 = u.pm * 256 + wr * 64 + fr, col0 = u.pn * 256 + wc * 32 + 8 * fq;
#pragma unroll
        for (int ai = 0; ai < 2; ++ai)
#pragma unroll
            for (int m = 0; m < 4; ++m)
                {
#pragma unroll
                  for (int bj = 0; bj < 2; ++bj)
                    *(u32x4*)(o + (unsigned)((row0 + ai * 128 + m * 16) * DM + col0 + bj * 128)) = pack8(acc[ai][bj][m][0], acc[ai][bj][m][1]);
                  asm volatile("" ::: "memory"); }
    }
};
struct EpiPle {
    const bf16_t* hsrc; bf16_t* hdst; const bf16_t* pp; const float* part_in; float* part_out; const LAS float* tab; int pm0;
    __device__ __forceinline__ void operator()(const AccT& acc, const Unit& u, int wr, int wc, int fr, int fq) const {
        const int row0 = u.pm * 256 + wr * 64 + fr, col0 = u.pn * 256 + wc * 32 + 8 * fq;
        float rs[2][4]; row_scales(part_in, tab, pm0, u.pm, row0, wr, fr, fq, rs);
        u32x4 hv[2][2][2], pw[2][2][2];
#define PLE_LOAD(buf, b) do { _Pragma("unroll") for (int mm = 0; mm < 2; ++mm) _Pragma("unroll") for (int bj = 0; bj < 2; ++bj) { \
            const unsigned o_ = (unsigned)((row0 + ((b) >> 1) * 128 + (2 * ((b) & 1) + mm) * 16) * DM + col0 + bj * 128); hv[buf][mm][bj] = *(const u32x4*)(hsrc + o_); pw[buf][mm][bj] = *(const u32x4*)(pp + o_); } } while (0)
        PLE_LOAD(0, 0);
#pragma unroll
        for (int b = 0; b < 4; ++b) {
            const int ai = b >> 1, mp = b & 1, cur = b & 1;
            if (b < 3) { if (cur == 0) PLE_LOAD(1, b + 1); else PLE_LOAD(0, b + 1); }
#pragma unroll
            for (int mm = 0; mm < 2; ++mm) {
                const int m = 2 * mp + mm, row = row0 + ai * 128 + m * 16; const float s = rs[ai][m]; float ss = 0.f;
#pragma unroll
                for (int bj = 0; bj < 2; ++bj) {
                    const unsigned o = (unsigned)(row * DM + col0 + bj * 128);
                    const f32x4 h0 = unpk_lo(hv[cur][mm][bj]) + sigm4(acc[ai][bj][m][0] * s) * unpk_lo(pw[cur][mm][bj]), h1 = unpk_hi(hv[cur][mm][bj]) + sigm4(acc[ai][bj][m][1] * s) * unpk_hi(pw[cur][mm][bj]);
                    *(u32x4*)(hdst + o) = pack8(h0, h1);
                    ss += sumsq8(h0, h1);
                }
                ss += __shfl_xor(ss, 16); ss += __shfl_xor(ss, 32);
                if (fq == 0) part_out[(unsigned)(row * 32 + 4 * u.pn + wc)] = ss;
            }
        }
#undef PLE_LOAD
    }
};

template <int MODE>
__device__ __forceinline__ void conv_item(const float* __restrict__ W, const float* __restrict__ gain, int K, int N, bf16_t* __restrict__ WT, int kb, int nb, LAS float* scr, int lane) {
    const int k0 = kb * 64, n0 = nb * 64, cc = lane & 15, kr = lane >> 4;
    f32x4 v[16];
#pragma unroll
    for (int i = 0; i < 16; ++i) { const int kk = 4 * i + kr, n = n0 + 4 * cc;
        v[i] = (n < N) ? __builtin_nontemporal_load((const f32x4*)(W + (size_t)(k0 + kk) * N + n)) : (f32x4){0.f, 0.f, 0.f, 0.f}; }
#pragma unroll
    for (int i = 0; i < 16; ++i) { const int kk = 4 * i + kr; const float g = gain ? gain[k0 + kk] : 1.0f;
        LAS float* d = scr + kk * 65 + 4 * cc; d[0] = v[i][0] * g; d[1] = v[i][1] * g; d[2] = v[i][2] * g; d[3] = v[i][3] * g; }
    LDS_WAIT();
    const int c = lane & 7, nl = lane >> 3;
#pragma unroll
    for (int j = 0; j < 8; ++j) { const int n = nl + 8 * j; const LAS float* s = scr + (8 * c) * 65 + n;
        u32x4 o; o.x = cvt_pk_bf16(s[0], s[65]); o.y = cvt_pk_bf16(s[130], s[195]); o.z = cvt_pk_bf16(s[260], s[325]); o.w = cvt_pk_bf16(s[390], s[455]);
        const int ng = n0 + n; int row = ng;
        if (MODE == 1) { row = (ng < FF) ? (256 * (ng >> 7) + (ng & 127)) : (256 * ((ng - FF) >> 7) + 128 + ((ng - FF) & 127)); }
        *(u32x4*)(WT + (size_t)row * K + k0 + 8 * c) = o; }
    LDS_WAIT();
}


#define XB_TMO      128
#define XB_XCNT(j)  (256  + 64 * (j))
#define XB_XSUB(j)  (1280 + 64 * (j))
#define XB_XGEN(j)  (2304 + 64 * (j))
#define XB_TOP      3328
#define XB_TOPGEN   3392
#define XCD_BAR_WORDS 3456
#define XB_SPIN_CAP (1u << 22)
__device__ __forceinline__ unsigned xb_ld(unsigned* p)              { return __hip_atomic_load(p, __ATOMIC_RELAXED, __HIP_MEMORY_SCOPE_AGENT); }
__device__ __forceinline__ unsigned xb_add(unsigned* p, unsigned v) { return __hip_atomic_fetch_add(p, v, __ATOMIC_RELAXED, __HIP_MEMORY_SCOPE_AGENT); }
__device__ __forceinline__ unsigned xb_xcc_id() { return (unsigned)__builtin_amdgcn_s_getreg((3 << 11) | 20) & 0xFu; }
#define XB_SPIN(cond, bar) do { unsigned _sp = 0; while (cond) { __builtin_amdgcn_s_sleep(1); \
    if ((++_sp & 255u) == 0u) { if (xb_ld(&(bar)[XB_TMO])) break; if (_sp > XB_SPIN_CAP) { atomicAdd(&(bar)[XB_TMO], 1u); break; } } } } while (0)
__device__ __forceinline__ void xcd_barrier_complete(unsigned* bar, unsigned x, unsigned& nloc, unsigned& nx) {
    const unsigned G = gridDim.x;
    unsigned sum, cnt, mine, sp = 0u;
    for (;;) {
        sum = 0u; cnt = 0u; mine = 0u;
#pragma unroll
        for (unsigned j = 0; j < 16; ++j) { const unsigned c = xb_ld(&bar[XB_XCNT(j)]); sum += c; cnt += (c > 0u) ? 1u : 0u; mine = (j == x) ? c : mine; }
        if (sum == G) break;
        __builtin_amdgcn_s_sleep(1);
        if ((++sp & 255u) == 0u) { if (xb_ld(&bar[XB_TMO])) break; if (sp > XB_SPIN_CAP) { atomicAdd(&bar[XB_TMO], 1u); break; } }
    }
    nloc = mine > 0u ? mine : 1u; nx = cnt > 0u ? cnt : 1u;
}
__device__ __forceinline__ void xcd_barrier(unsigned* bar, volatile LAS unsigned* st) {
    asm volatile("s_waitcnt vmcnt(0)" ::: "memory");
    __syncthreads();
    if (threadIdx.x == 0) {
        const unsigned x = xb_xcc_id();
        __builtin_amdgcn_s_waitcnt(0);
        unsigned nloc = st[0], nx = st[1];
        if (nloc == 0u) { xcd_barrier_complete(bar, x, nloc, nx); st[0] = nloc; st[1] = nx; }
        const unsigned old = xb_add(&bar[XB_XSUB(x)], 1u);
        const unsigned gen = old / nloc;
        if (old + 1u == (gen + 1u) * nloc) {
            __builtin_amdgcn_fence(__ATOMIC_RELEASE, "agent");
            asm volatile("s_waitcnt vmcnt(0)" ::: "memory");
            const unsigned og = xb_add(&bar[XB_TOP], 1u);
            const unsigned tg = og / nx;
            if (og + 1u == (tg + 1u) * nx) xb_add(&bar[XB_TOPGEN], 1u);
            else XB_SPIN(xb_ld(&bar[XB_TOPGEN]) == tg, bar);
            __builtin_amdgcn_fence(__ATOMIC_ACQUIRE, "agent");
            asm volatile("s_waitcnt vmcnt(0)" ::: "memory");
        } else {
            XB_SPIN(xb_ld(&bar[XB_TOPGEN]) == gen, bar);
            __builtin_amdgcn_fence(__ATOMIC_ACQUIRE, "agent");
            asm volatile("s_waitcnt vmcnt(0)" ::: "memory");
        }
    }
    __syncthreads();
}

__device__ __forceinline__ unsigned xcd_barrier_arrive(unsigned* bar, volatile LAS unsigned* st) {
    unsigned gen = 0u;
    asm volatile("s_waitcnt vmcnt(0)" ::: "memory");
    __syncthreads();
    if (threadIdx.x == 0) {
        const unsigned x = xb_xcc_id();
        __builtin_amdgcn_s_waitcnt(0);
        unsigned nloc = st[0], nx = st[1];
        if (nloc == 0u) { xcd_barrier_complete(bar, x, nloc, nx); st[0] = nloc; st[1] = nx; }
        const unsigned old = xb_add(&bar[XB_XSUB(x)], 1u);
        gen = old / nloc;
        if (old + 1u == (gen + 1u) * nloc) {
            __builtin_amdgcn_fence(__ATOMIC_RELEASE, "agent");
            asm volatile("s_waitcnt vmcnt(0)" ::: "memory");
            const unsigned og = xb_add(&bar[XB_TOP], 1u);
            const unsigned tg = og / nx;
            if (og + 1u == (tg + 1u) * nx) xb_add(&bar[XB_TOPGEN], 1u);
        }
    }
    return gen;
}
__device__ __forceinline__ void xcd_barrier_wait(unsigned* bar, unsigned gen) {
    if (threadIdx.x == 0) {
        XB_SPIN(xb_ld(&bar[XB_TOPGEN]) == gen, bar);
        __builtin_amdgcn_fence(__ATOMIC_ACQUIRE, "agent");
        asm volatile("s_waitcnt vmcnt(0)" ::: "memory");
    }
    __syncthreads();
}

struct Args { const float* in[21]; float* out; unsigned char* ws; };
typedef const __attribute__((address_space(4))) char* kptr_t;
__device__ __forceinline__ const float* in_ptr(int i) { int off = i * 8; asm volatile("" : "+s"(off)); kptr_t kp = (kptr_t)__builtin_amdgcn_kernarg_segment_ptr(); return *(const float* const __attribute__((address_space(4)))*)(kp + off); }
__device__ __forceinline__ float* out_ptr() { return (float*)in_ptr(21); }
__device__ __forceinline__ unsigned char* ws_ptr() { return (unsigned char*)in_ptr(22); }
enum { I_X = 0, I_P, I_F1N, I_F1I, I_F1O, I_MXN, I_MXI, I_SGVG, I_SGW, I_SGB, I_GWG, I_GBG, I_GOG, I_MXO, I_F2N, I_F2I, I_F2O, I_PLN, I_PLG, I_PLP, I_FIN };

constexpr int I_1I = (DM / 64) * (NIN / 64), I_1O = (FF / 64) * (DM / 64), I_MI = (DM / 64) * (NMIXP / 64), I_MO = (DM / 64) * (DM / 64), I_PP = (DPLE / 64) * (DM / 64);
constexpr int PER_LAYER = 2 * I_1I + 2 * I_1O + I_MI + 2 * I_MO + I_PP;
constexpr int CV_PRO = I_1I;
constexpr int CV_E0 = CV_PRO + 8000;
constexpr int CV_E2 = CV_E0 + 5120;
constexpr int CV_E7 = PER_LAYER + I_1I;
constexpr int CV_E10 = CV_E7 + 8000, CV_E12 = CV_E10 + 5120, CV_E17 = 2 * PER_LAYER;
static_assert(CV_E0 >= CV_PRO + I_1O + I_MI && CV_E2 >= CV_PRO + I_1O + I_MI + I_PP + I_MO + I_1I && CV_E2 <= CV_E7 && CV_E10 >= CV_E7 + I_1O + I_MI && CV_E12 >= CV_E7 + I_1O + I_MI + I_PP + I_MO + I_1I && CV_E12 <= CV_E17, "every weight range is converted at least one barrier before its first use");
__device__ __forceinline__ void convert_items(LAS unsigned char* lds, int it0, int it1, int worker, int nworkers) {
    const int tid = opaque_tid(), lane = tid & 63, wave = __builtin_amdgcn_readfirstlane(tid >> 6);
    LAS float* scr = (LAS float*)(lds + wave * 16640);
    unsigned char* ws = ws_ptr();
    for (int it = it0 + worker * 8 + wave; it < it1; it += nworkers * 8) {
        const int l = (it >= PER_LAYER) ? 1 : 0; int r = it - l * PER_LAYER;
        unsigned char* wl = ws + (size_t)l * SZ_LAYER;
#define CONV(MODE, src, gain, K, N, NPAD, dstoff) { constexpr int nbk = (NPAD) / 64, cnt = ((K) / 64) * nbk; \
        if (r < cnt) { conv_item<MODE>((src) + (size_t)l * (K) * (N), (gain), (K), (N), (bf16_t*)(wl + (dstoff)), r / nbk, r % nbk, scr, lane); continue; } r -= cnt; }
        CONV(1, in_ptr(I_F1I), in_ptr(I_F1N) + l * DM, DM, NIN, NIN, OFF_W1I)
        CONV(0, in_ptr(I_F1O), (const float*)nullptr, FF, DM, DM, OFF_W1O)
        CONV(0, in_ptr(I_MXI), in_ptr(I_MXN) + l * DM, DM, NMIX, NMIXP, OFF_WMI)
        CONV(0, in_ptr(I_PLP), (const float*)nullptr, DPLE, DM, DM, OFF_WPP)
        CONV(0, in_ptr(I_MXO), (const float*)nullptr, DM, DM, DM, OFF_WMO)
        CONV(1, in_ptr(I_F2I), in_ptr(I_F2N) + l * DM, DM, NIN, NIN, OFF_W2I)
        CONV(0, in_ptr(I_F2O), (const float*)nullptr, FF, DM, DM, OFF_W2O)
        CONV(0, in_ptr(I_PLG), in_ptr(I_PLN) + l * DM, DM, DM, DM, OFF_WPG)
#undef CONV
    }
}
__device__ __forceinline__ void prologue(LAS unsigned char* lds, int G) {
    const int tid = opaque_tid(), lane = tid & 63, wave = __builtin_amdgcn_readfirstlane(tid >> 6);
    const int gw = blockIdx.x * 8 + wave, NGW = G * 8;
    unsigned char* ws = ws_ptr();
    bf16_t* HB = (bf16_t*)(ws + WS_HB); float* PA = (float*)(ws + WS_PARTA);
    for (int m = 4 * gw; m < MTOK; m += 4 * NGW) {
        f32x4 v[4][8]; float sq[4];
#pragma unroll
        for (int r = 0; r < 4; ++r) { const f32x4* xr = (const f32x4*)(in_ptr(I_X) + (size_t)(m + r) * DM) + lane;
#pragma unroll
            for (int j = 0; j < 8; ++j) v[r][j] = xr[64 * j]; }
#pragma unroll
        for (int r = 0; r < 4; ++r) { float t = 0.f;
#pragma unroll
            for (int j = 0; j < 8; ++j) t += (v[r][j][0] * v[r][j][0] + v[r][j][1] * v[r][j][1]) + (v[r][j][2] * v[r][j][2] + v[r][j][3] * v[r][j][3]);
            sq[r] = wave_sum(t); }
#pragma unroll
        for (int r = 0; r < 4; ++r) { u32x2* o8 = (u32x2*)(HB + (size_t)(m + r) * DM) + lane;
#pragma unroll
            for (int j = 0; j < 8; ++j) { u32x2 w; w.x = cvt_pk_bf16(v[r][j][0], v[r][j][1]); w.y = cvt_pk_bf16(v[r][j][2], v[r][j][3]); o8[64 * j] = w; }
            if (lane < 32) PA[(size_t)(m + r) * 32 + lane] = (lane == 0) ? sq[r] : 0.f; }
    }
}
__device__ __forceinline__ void prologue_p(int G) {
    const int tid = opaque_tid(), lane = tid & 63, wave = __builtin_amdgcn_readfirstlane(tid >> 6);
    const int gw = blockIdx.x * 8 + wave, NGW = G * 8;
    unsigned char* ws = ws_ptr();
    bf16_t* PB = (bf16_t*)(ws + WS_PB);
    for (int m = 4 * gw; m < 2 * MTOK; m += 4 * NGW) {
        f32x4 v[4];
#pragma unroll
        for (int r = 0; r < 4; ++r) v[r] = *((const f32x4*)(in_ptr(I_P) + (size_t)(m + r) * DPLE) + lane);
#pragma unroll
        for (int r = 0; r < 4; ++r) { u32x2 w; w.x = cvt_pk_bf16(v[r][0], v[r][1]); w.y = cvt_pk_bf16(v[r][2], v[r][3]); *((u32x2*)(PB + (size_t)(m + r) * DPLE) + lane) = w; }
    }
}

#define MFMA16(X, Y, C) __builtin_amdgcn_mfma_f32_16x16x32_bf16((X), (Y), (C), 0, 0, 0)
__device__ __forceinline__ void sg_unit(LAS unsigned char* lds, int unit, int l) {
    const int tid = opaque_tid(), lane = tid & 63, w = __builtin_amdgcn_readfirstlane(tid >> 6), fr = lane & 15, fq = lane >> 4;
    const int h = unit & 7, t0 = (unit >> 3) * 128;
    LAS bf16_t* Vt = (LAS bf16_t*)lds;
    LAS bf16_t* Wl = (LAS bf16_t*)(lds + 34816);
    LAS float* red = (LAS float*)(lds + 69632);
    const bf16_t* MX = (const bf16_t*)(ws_ptr() + WS_MX); bf16_t* YM = (bf16_t*)(ws_ptr() + WS_YM);
    const int s = tid & 127, part = tid >> 7;
    float x[32];
    {
        const u32x4* src = (const u32x4*)(MX + (size_t)(t0 + s) * MXW + 1024 + h * 128 + 32 * part);
        float sum = 0.f, sq = 0.f;
#pragma unroll
        for (int j = 0; j < 4; ++j) { const u32x4 q = src[j];
            x[8 * j + 0] = bf_lo(q.x); x[8 * j + 1] = bf_hi(q.x); x[8 * j + 2] = bf_lo(q.y); x[8 * j + 3] = bf_hi(q.y);
            x[8 * j + 4] = bf_lo(q.z); x[8 * j + 5] = bf_hi(q.z); x[8 * j + 6] = bf_lo(q.w); x[8 * j + 7] = bf_hi(q.w); }
#pragma unroll
        for (int e = 0; e < 32; ++e) { sum += x[e]; sq += x[e] * x[e]; }
        red[part * 128 + s] = sum; red[512 + part * 128 + s] = sq;
    }
    {
        const float* wsrc = in_ptr(I_SGW) + (size_t)(l * 8 + h) * 128 * 128;
#pragma unroll
        for (int j = 0; j < 8; ++j) { const int idx = tid + 512 * j, t = idx >> 5, c4 = idx & 31;
            f32x4 wv = *(const f32x4*)(wsrc + t * 128 + 4 * c4);
#pragma unroll
            for (int e = 0; e < 4; ++e) if (4 * c4 + e > t) wv[e] = 0.f;
            u32x2 o; o.x = cvt_pk_bf16(wv[0], wv[1]); o.y = cvt_pk_bf16(wv[2], wv[3]);
            *(LAS u32x2*)(Wl + t * 136 + 4 * c4) = o; }
    }
    __syncthreads();
    {
        const float sum = (red[s] + red[128 + s]) + (red[256 + s] + red[384 + s]), sq = (red[512 + s] + red[640 + s]) + (red[768 + s] + red[896 + s]);
        const float mean = sum * (1.0f / 128.0f), var = fmaxf(sq * (1.0f / 128.0f) - mean * mean, 0.f), rstd = rsqrtf(var + EPS);
        const float* gv = in_ptr(I_SGVG) + l * 1024 + h * 128 + 32 * part;
#pragma unroll
        for (int e = 0; e < 32; ++e) Vt[(32 * part + e) * 136 + s] = f2bf((x[e] - mean) * rstd * gv[e]);
    }
    __syncthreads();
    const int tq = 16 * w + fr; const float bias = in_ptr(I_SGB)[(l * 8 + h) * 128 + tq];
    const bf16_t* urow = MX + (size_t)(t0 + tq) * MXW + h * 128 + 4 * fq;
    u32x2 uuv[8];
#pragma unroll
    for (int nt = 0; nt < 8; ++nt) uuv[nt] = *(const u32x2*)(urow + 16 * nt);
    f32x4 acc[8];
#pragma unroll
    for (int nt = 0; nt < 8; ++nt) acc[nt] = (f32x4){0.f, 0.f, 0.f, 0.f};
    const int nks = (w >> 1) + 1;
    for (int ks = 0; ks < nks; ++ks) {
        const bf16x8 A = *(const LAS bf16x8*)(Wl + (16 * w + fr) * 136 + 32 * ks + 8 * fq);
#pragma unroll
        for (int nt = 0; nt < 8; ++nt) { const bf16x8 B = *(const LAS bf16x8*)(Vt + (16 * nt + fr) * 136 + 32 * ks + 8 * fq); acc[nt] = MFMA16(B, A, acc[nt]); }
    }
    {
        bf16_t* yrow = YM + (size_t)(t0 + tq) * DM + h * 128 + 4 * fq;
#pragma unroll
        for (int nt = 0; nt < 8; ++nt) { const u32x2 uu = uuv[nt];
            u32x2 o; o.x = cvt_pk_bf16(bf_lo(uu.x) * (acc[nt][0] + bias), bf_hi(uu.x) * (acc[nt][1] + bias)); o.y = cvt_pk_bf16(bf_lo(uu.y) * (acc[nt][2] + bias), bf_hi(uu.y) * (acc[nt][3] + bias));
            *(u32x2*)(yrow + 16 * nt) = o; }
    }
    __syncthreads();
}

constexpr int GL_QS = 0, GL_KS = 17408, GL_VT = 34816, GL_PS = 71680, GL_KD = 80896, GL_ZS = 99328, GL_TOT = 103424, GL_SS = 105472;
constexpr int GC = 128, NCH = SEQ / GC;
constexpr int GA_VT = 0, GA_KD = 69632, GA_ZS = 104448, GA_TOT = 112640;
constexpr int GCc_VT = 0, GCc_PS = 69632;
__device__ __forceinline__ void gla_a_unit(LAS unsigned char* lds, int unit, int l) {
    const int tid = opaque_tid(), lane = tid & 63, w = __builtin_amdgcn_readfirstlane(tid >> 6), fr = lane & 15, fq = lane >> 4;
    const int bh = unit / NCH, c = unit - bh * NCH, b = bh >> 2, h = bh & 3, t0 = b * SEQ + GC * c;
    LAS bf16_t* Vt = (LAS bf16_t*)(lds + GA_VT); LAS bf16_t* KDt = (LAS bf16_t*)(lds + GA_KD);
    LAS float* Zs = (LAS float*)(lds + GA_ZS); LAS float* TOT = (LAS float*)(lds + GA_TOT);
    const bf16_t* MX = (const bf16_t*)(ws_ptr() + WS_MX); const float* ZB = (const float*)(ws_ptr() + WS_ZB);
    *(LAS f32x4*)(Zs + tid * 4) = *(const f32x4*)(ZB + (size_t)t0 * 16 + tid * 4);
#pragma unroll
    for (int p = 0; p < 2; ++p) {
        const u32x4* src = (const u32x4*)(MX + (size_t)(t0 + 64 * p + lane) * MXW + 3072 + h * 256 + 32 * w);
#pragma unroll
        for (int j = 0; j < 4; ++j) { const u32x4 q = src[j]; LAS bf16_t* d = Vt + (32 * w + 8 * j) * 136 + 64 * p + lane;
            d[0] = (bf16_t)(q.x & 0xffff); d[136] = (bf16_t)(q.x >> 16); d[272] = (bf16_t)(q.y & 0xffff); d[408] = (bf16_t)(q.y >> 16);
            d[544] = (bf16_t)(q.z & 0xffff); d[680] = (bf16_t)(q.z >> 16); d[816] = (bf16_t)(q.w & 0xffff); d[952] = (bf16_t)(q.w >> 16); }
    }
    const int kk = tid & 127, tg = tid >> 7;
    bf16_t qraw[32], kraw[32];
    { const bf16_t* qsrc0 = MX + (size_t)(t0 + 32 * tg) * MXW + 2048 + h * 128 + kk;
#pragma unroll
      for (int i = 0; i < 32; ++i) { kraw[i] = qsrc0[(size_t)i * MXW + 512]; qraw[i] = qsrc0[(size_t)i * MXW]; } }
    float wg[16];
#pragma unroll
    for (int r = 0; r < 16; ++r) wg[r] = in_ptr(I_GWG)[(size_t)(l * 16 + r) * 512 + h * 128 + kk];
    const float bg = in_ptr(I_GBG)[l * 512 + h * 128 + kk];
    __syncthreads();
    float bl[32]; float cum = 0.f;
#pragma unroll
    for (int i = 0; i < 32; ++i) { const LAS float* z = Zs + (32 * tg + i) * 16; float g = bg;
#pragma unroll
        for (int r = 0; r < 16; ++r) g += z[r] * wg[r];
        const float ls = fminf(g, 0.f) - __logf(1.0f + __expf(-fabsf(g)));
        cum += ls * (1.0f / 16.0f); bl[i] = cum; }
    TOT[tg * 128 + kk] = cum;
    __syncthreads();
    float off = 0.f, blast = 0.f;
#pragma unroll
    for (int g = 0; g < 4; ++g) { const float t = TOT[g * 128 + kk]; blast += t; if (g < tg) off += t; }
    bf16_t* qt = (bf16_t*)(ws_ptr() + WS_QT) + (size_t)(t0 + 32 * tg) * 1024 + h * 256 + kk;
#pragma unroll
    for (int i8 = 0; i8 < 4; ++i8) {
        float kd[8];
#pragma unroll
        for (int e = 0; e < 8; ++e) { const int i = 8 * i8 + e; const float bb = bl[i] + off, kv = bf_one(kraw[i]);
            kd[e] = kv * __expf(blast - bb);
            qt[(size_t)i * 1024] = f2bf(bf_one(qraw[i]) * __expf(bb)); qt[(size_t)i * 1024 + 128] = f2bf(kv * __expf(-bb)); }
        u32x4 o; o.x = cvt_pk_bf16(kd[0], kd[1]); o.y = cvt_pk_bf16(kd[2], kd[3]); o.z = cvt_pk_bf16(kd[4], kd[5]); o.w = cvt_pk_bf16(kd[6], kd[7]);
        *(LAS u32x4*)(KDt + kk * 136 + 32 * tg + 8 * i8) = o;
    }
    if (tg == 0) ((float*)(ws_ptr() + WS_DEC))[(size_t)(bh * NCH + c) * 128 + kk] = __expf(blast);
    __syncthreads();
    f32x4 acc[2][8];
#pragma unroll
    for (int mi = 0; mi < 2; ++mi)
#pragma unroll
        for (int nt = 0; nt < 8; ++nt) acc[mi][nt] = (f32x4){0.f, 0.f, 0.f, 0.f};
#pragma unroll
    for (int ks = 0; ks < 4; ++ks) {
        const bf16x8 A0 = *(const LAS bf16x8*)(Vt + (32 * w + fr) * 136 + 32 * ks + 8 * fq), A1 = *(const LAS bf16x8*)(Vt + (32 * w + 16 + fr) * 136 + 32 * ks + 8 * fq);
#pragma unroll
        for (int nt = 0; nt < 8; ++nt) { const bf16x8 B = *(const LAS bf16x8*)(KDt + (16 * nt + fr) * 136 + 32 * ks + 8 * fq);
            acc[0][nt] = MFMA16(B, A0, acc[0][nt]); acc[1][nt] = MFMA16(B, A1, acc[1][nt]); }
    }
    float* UT = (float*)(ws_ptr() + WS_ACT) + (size_t)(bh * NCH + c) * 256 * 128;
#pragma unroll
    for (int mi = 0; mi < 2; ++mi)
#pragma unroll
        for (int nt = 0; nt < 8; ++nt) *(f32x4*)(UT + (size_t)(32 * w + 16 * mi + fr) * 128 + 16 * nt + 4 * fq) = acc[mi][nt];
    __syncthreads();
}
__device__ __forceinline__ void gla_c_unit(LAS unsigned char* lds, int unit, int l) {
    const int tid = opaque_tid(), lane = tid & 63, w = __builtin_amdgcn_readfirstlane(tid >> 6), fr = lane & 15, fq = lane >> 4;
    const int bh = unit / NCH, c = unit - bh * NCH, b = bh >> 2, h = bh & 3, t0 = b * SEQ + GC * c;
    LAS bf16_t* Vt = (LAS bf16_t*)(lds + GCc_VT); LAS bf16_t* Ps = (LAS bf16_t*)(lds + GCc_PS);
    const bf16_t* MX = (const bf16_t*)(ws_ptr() + WS_MX);
    const int i = 16 * w + fr;
    const bf16_t* QT = (const bf16_t*)(ws_ptr() + WS_QT) + (size_t)t0 * 1024 + h * 256;
    bf16x8 Aq[4];
#pragma unroll
    for (int ks = 0; ks < 4; ++ks) Aq[ks] = *(const bf16x8*)(QT + (size_t)i * 1024 + 32 * ks + 8 * fq);
#pragma unroll
    for (int p = 0; p < 2; ++p) {
        const u32x4* src = (const u32x4*)(MX + (size_t)(t0 + 64 * p + lane) * MXW + 3072 + h * 256 + 32 * w);
#pragma unroll
        for (int j = 0; j < 4; ++j) { const u32x4 q = src[j]; LAS bf16_t* d = Vt + (32 * w + 8 * j) * 136 + 64 * p + lane;
            d[0] = (bf16_t)(q.x & 0xffff); d[136] = (bf16_t)(q.x >> 16); d[272] = (bf16_t)(q.y & 0xffff); d[408] = (bf16_t)(q.y >> 16);
            d[544] = (bf16_t)(q.z & 0xffff); d[680] = (bf16_t)(q.z >> 16); d[816] = (bf16_t)(q.w & 0xffff); d[952] = (bf16_t)(q.w >> 16); }
    }
#pragma unroll
    for (int nt = 0; nt < 8; ++nt) {
        f32x4 p = (f32x4){0.f, 0.f, 0.f, 0.f};
        if (nt <= w) {
#pragma unroll
            for (int ks = 0; ks < 4; ++ks) { const bf16x8 B = *(const bf16x8*)(QT + (size_t)(16 * nt + fr) * 1024 + 128 + 32 * ks + 8 * fq); p = MFMA16(B, Aq[ks], p); }
        }
        const int j0 = 16 * nt + 4 * fq;
#pragma unroll
        for (int jj = 0; jj < 4; ++jj) if (j0 + jj > i) p[jj] = 0.f;
        u32x2 o; o.x = cvt_pk_bf16(p[0], p[1]); o.y = cvt_pk_bf16(p[2], p[3]);
        *(LAS u32x2*)(Ps + i * 136 + j0) = o;
    }
    f32x4 acc[16];
#pragma unroll
    for (int nt = 0; nt < 16; ++nt) acc[nt] = (f32x4){0.f, 0.f, 0.f, 0.f};
    const bf16_t* ST = (const bf16_t*)(ws_ptr() + WS_ST) + (size_t)(bh * NCH + c) * 256 * 128;
#pragma unroll
    for (int nt = 0; nt < 16; ++nt) { const bf16_t* srow = ST + (size_t)(16 * nt + fr) * 128 + 8 * fq;
#pragma unroll
        for (int ks = 0; ks < 4; ++ks) { const bf16x8 B = *(const bf16x8*)(srow + 32 * ks); acc[nt] = MFMA16(B, Aq[ks], acc[nt]); } }
    const float* og = in_ptr(I_GOG) + l * 1024 + h * 256 + 4 * fq;
    const bf16_t* rrow = MX + (size_t)(t0 + i) * MXW + 4096 + h * 256 + 4 * fq;
    f32x4 g4v[16]; u32x2 rrv[16];
#pragma unroll
    for (int nt = 0; nt < 16; ++nt) { g4v[nt] = *(const f32x4*)(og + 16 * nt); rrv[nt] = *(const u32x2*)(rrow + 16 * nt); }
    __syncthreads();
    const int nks = (w >> 1) + 1;
#pragma unroll
    for (int ks = 0; ks < 4; ++ks) if (ks < nks) { const bf16x8 A = *(const LAS bf16x8*)(Ps + i * 136 + 32 * ks + 8 * fq);
#pragma unroll
        for (int nt = 0; nt < 16; ++nt) { const bf16x8 B = *(const LAS bf16x8*)(Vt + (16 * nt + fr) * 136 + 32 * ks + 8 * fq); acc[nt] = MFMA16(B, A, acc[nt]); } }
    float ss = 0.f;
#pragma unroll
    for (int nt = 0; nt < 16; ++nt) ss += (acc[nt][0] * acc[nt][0] + acc[nt][1] * acc[nt][1]) + (acc[nt][2] * acc[nt][2] + acc[nt][3] * acc[nt][3]);
    ss += __shfl_xor(ss, 16); ss += __shfl_xor(ss, 32);
    const float rstd = rsqrtf(ss * (1.0f / 256.0f) + EPS);
    bf16_t* yrow = (bf16_t*)(ws_ptr() + WS_YM) + (size_t)(t0 + i) * DM + 1024 + h * 256 + 4 * fq;
#pragma unroll
    for (int nt = 0; nt < 16; ++nt) { const f32x4 g4 = g4v[nt]; const u32x2 rr = rrv[nt];
        u32x2 o; o.x = cvt_pk_bf16(acc[nt][0] * rstd * g4[0] * bf_lo(rr.x), acc[nt][1] * rstd * g4[1] * bf_hi(rr.x));
        o.y = cvt_pk_bf16(acc[nt][2] * rstd * g4[2] * bf_lo(rr.y), acc[nt][3] * rstd * g4[3] * bf_hi(rr.y));
        *(u32x2*)(yrow + 16 * nt) = o; }
    __syncthreads();
}

__device__ __forceinline__ void gla_scan(int G) {
    const float* UT = (const float*)(ws_ptr() + WS_ACT); const float* DEC = (const float*)(ws_ptr() + WS_DEC); bf16_t* ST = (bf16_t*)(ws_ptr() + WS_ST);
    for (int idx = blockIdx.x * NTHREADS + opaque_tid(); idx < 8 * 256 * 64; idx += G * NTHREADS) {
        const int e = idx * 2, kk = e & 127, dv = (e >> 7) & 255, bh = e >> 15;
        f32x2 S = (f32x2){0.f, 0.f};
        const size_t base = ((size_t)bh * NCH * 256 + dv) * 128 + kk;
#pragma unroll 8
        for (int c = 0; c < NCH; ++c) {
            const f32x2 u = *(const f32x2*)(UT + base + (size_t)c * 256 * 128);
            const f32x2 d = *(const f32x2*)(DEC + (size_t)(bh * NCH + c) * 128 + kk);
            *(unsigned*)(ST + base + (size_t)c * 256 * 128) = cvt_pk_bf16(S[0], S[1]);
            S = S * d + u;
        }
    }
}

__global__ void __launch_bounds__(NTHREADS, 2) fwd_megakernel(Args a) {
    extern __shared__ __attribute__((aligned(16))) unsigned char lds_raw[];
    LAS unsigned char* lds = (LAS unsigned char*)lds_raw;
    cg::grid_group grid = cg::this_grid();
    const int G = gridDim.x;
    volatile LAS unsigned* bst = (volatile LAS unsigned*)(lds + 134144);
    if (threadIdx.x < 2) bst[threadIdx.x] = 0u;
    __syncthreads();
    if (threadIdx.x == 0) (void)xb_add(&((unsigned*)(ws_ptr() + WS_BAR))[XB_XCNT(xb_xcc_id())], 1u);
#define GRID_BAR() xcd_barrier((unsigned*)(ws_ptr() + WS_BAR), bst)
#define WSB(off) ((bf16_t*)(ws_ptr() + (off)))
#define WSF(off) ((float*)(ws_ptr() + (off)))
    if (G == 0x7fffffff) grid.sync();
    const bool win = (G == 256);
    int probe_rep = PROBE_MIX;
    for (int st = -1; st < 20; ++st) {
        int c0 = 0, c1 = 0, cw = (int)blockIdx.x, cn = G;
        if (st < 0) { prologue(lds, G); c1 = win ? CV_PRO : 2 * PER_LAYER; }
        else {
        const int l = st / 10, k = st - 10 * l;
        if (win) {
            if (k == 0) { c0 = l ? CV_E7 : CV_PRO; c1 = l ? CV_E10 : CV_E0; cw -= 128; cn = 128; }
            else if (k == 2) { c0 = l ? CV_E10 : CV_E0; c1 = l ? CV_E12 : CV_E2; cw -= 160; cn = 96; }
            else if (k == 7) { c0 = l ? CV_E12 : CV_E2; c1 = l ? CV_E17 : CV_E7; cw -= 128; cn = 128; }
        }
        const size_t lo = (size_t)l * SZ_LAYER;
        const size_t hbo = (l & 1) ? WS_HB2 : WS_HB, hbn = (l & 1) ? WS_HB : WS_HB2;
        pg8::StaticOrder S;
        if (k == 0 || k == 7) {
            pg8::Gemm g{WSB(hbo), WSB(lo + (k == 0 ? OFF_W1I : OFF_W2I)), MTOK, NIN, DM}; S.init(MTOK, NIN, G, (int)blockIdx.x);
            pg8::Unit u0; const bool has0 = S.next(0, u0); LAS float* tab = (LAS float*)(lds + RSTD_OFF);
            EpiSwiglu E{WSB(WS_ACT), WSF(WS_PARTA), tab, has0 ? u0.pm : -1};
            pg8::gemm_phase(lds, g, S, E, TabPre{tab, WSF(WS_PARTA), u0.pm});
        } else if (k == 1 || k == 6 || k == 8) {
            pg8::Gemm g{(k == 6) ? WSB(WS_YM) : WSB(WS_ACT), WSB(lo + (k == 1 ? OFF_W1O : (k == 6 ? OFF_WMO : OFF_W2O))), MTOK, DM, (k == 6) ? DM : FF}; S.init(MTOK, DM, G, (int)blockIdx.x);
            EpiResid E{WSB(hbo), (k == 6) ? WSF(WS_PARTA) : WSF(WS_PARTB), (k == 6) ? 1.0f : 0.5f};
            pg8::gemm_phase(lds, g, S, E, pg8::NoPre{}, true);
        } else if (k == 2) {
            { pg8::Gemm g{WSB(hbo), WSB(lo + OFF_WMI), MTOK, NMIXP, DM}; S.init(MTOK, NMIXP, G, (int)blockIdx.x);
              pg8::Unit u0; const bool has0 = S.next(0, u0); LAS float* tab = (LAS float*)(lds + RSTD_OFF);
              EpiMixIn E{WSB(WS_MX), WSF(WS_ZB), WSF(WS_PARTB), tab, has0 ? u0.pm : -1};
              pg8::gemm_phase(lds, g, S, E, TabPre{tab, WSF(WS_PARTB), u0.pm}); }
        } else if (k == 3 || k == 4) {
            if (k == 3) { for (int u = blockIdx.x; u < 8 * NCH; u += G) gla_a_unit(lds, u, l); } else gla_scan(G);
            const unsigned bgen = xcd_barrier_arrive((unsigned*)(ws_ptr() + WS_BAR), bst);
            for (int u = (k == 3 ? 0 : 256) + (int)blockIdx.x; u < (k == 3 ? 256 : 512); u += G) sg_unit(lds, u, l);
            xcd_barrier_wait((unsigned*)(ws_ptr() + WS_BAR), bgen);
            continue;
        } else if (k == 5) {
            for (int u = blockIdx.x; u < 8 * NCH; u += G) gla_c_unit(lds, u, l);
            {
                const unsigned bgen = xcd_barrier_arrive((unsigned*)(ws_ptr() + WS_BAR), bst);
                pg8::Gemm g{WSB(WS_PB) + (size_t)l * MTOK * DPLE, WSB(lo + OFF_WPP), MTOK, DM, DPLE}; S.init(MTOK, DM, G, (int)blockIdx.x);
                EpiStore E{WSB(WS_PP)};
                pg8::gemm_phase(lds, g, S, E, pg8::NoPre{});
                xcd_barrier_wait((unsigned*)(ws_ptr() + WS_BAR), bgen);
                continue;
            }
        } else {
            pg8::Gemm g{WSB(hbo), WSB(lo + OFF_WPG), MTOK, DM, DM}; S.init(MTOK, DM, G, (int)blockIdx.x);
            pg8::Unit u0; const bool has0 = S.next(0, u0); LAS float* tab = (LAS float*)(lds + RSTD_OFF);
            EpiPle E{WSB(hbo), WSB(hbn), WSB(WS_PP), WSF(WS_PARTB), WSF(WS_PARTA), tab, has0 ? u0.pm : -1};
            pg8::gemm_phase(lds, g, S, E, TabPre{tab, WSF(WS_PARTB), u0.pm});
        }
        }
        if (cw >= 0 && c0 < c1) convert_items(lds, c0, c1, cw, cn);
        if (st < 0) { const unsigned bgen = xcd_barrier_arrive((unsigned*)(ws_ptr() + WS_BAR), bst); prologue_p(G); xcd_barrier_wait((unsigned*)(ws_ptr() + WS_BAR), bgen); continue; }
        GRID_BAR();
    }
    {
        const int tid = opaque_tid(), lane = tid & 63, wave = tid >> 6, gw = blockIdx.x * 8 + wave, NGW = G * 8;
        const f32x4* gf = (const f32x4*)in_ptr(I_FIN) + 2 * lane;
        for (int m = 4 * gw; m < MTOK; m += 4 * NGW) {
            float ps[4]; u32x4 w[4][4];
#pragma unroll
            for (int r = 0; r < 4; ++r) { ps[r] = (lane < 32) ? WSF(WS_PARTA)[(size_t)(m + r) * 32 + lane] : 0.f;
                const u32x4* hrow = (const u32x4*)(WSB(WS_HB) + (size_t)(m + r) * DM) + lane;
#pragma unroll
                for (int j = 0; j < 4; ++j) w[r][j] = hrow[64 * j]; }
#pragma unroll
            for (int r = 0; r < 4; ++r) { const float rstd = rsqrtf(wave_sum(ps[r]) * (1.0f / DM) + EPS);
                f32x4* orow = (f32x4*)(out_ptr() + (size_t)(m + r) * DM) + 2 * lane;
#pragma unroll
                for (int j = 0; j < 4; ++j) { orow[128 * j] = unpk_lo(w[r][j]) * rstd * gf[128 * j]; orow[128 * j + 1] = unpk_hi(w[r][j]) * rstd * gf[128 * j + 1]; } }
        }
    }
}

extern "C" void kernel_launch(void* const* d_in, const int* in_sizes, int n_in, void* d_out, int out_size, void* d_ws, size_t ws_size, hipStream_t stream) {
    static int grid = 0;
    if (grid == 0) {
        if (n_in != 21 || out_size != MTOK * DM || ws_size < WS_END) { fprintf(stderr, "kernel_launch: unexpected shapes (n_in %d, out %d, ws %zu < %zu)\n", n_in, out_size, ws_size, (size_t)WS_END); grid = -1; return; }
        int dev = 0, cus = 0, per_cu = 0;
        hipGetDevice(&dev);
        hipDeviceGetAttribute(&cus, hipDeviceAttributeMultiprocessorCount, dev);
        hipFuncSetAttribute((const void*)fwd_megakernel, hipFuncAttributeMaxDynamicSharedMemorySize, LDS_BYTES);
        hipOccupancyMaxActiveBlocksPerMultiprocessor(&per_cu, (const void*)fwd_megakernel, NTHREADS, LDS_BYTES);
        if (per_cu < 1) { fprintf(stderr, "kernel_launch: occupancy query says %d blocks per CU\n", per_cu); per_cu = 1; }
        grid = cus * per_cu;
        (void)hipGetLastError();
    }
    if (grid < 0) return;
    if (hipMemsetAsync((char*)d_ws + WS_BAR, 0, BAR_BYTES, stream) != hipSuccess) { fprintf(stderr, "kernel_launch: memset of barrier words failed\n"); return; }
    Args a{};
    for (int i = 0; i < 21; ++i) a.in[i] = (const float*)d_in[i];
    a.out = (float*)d_out; a.ws = (unsigned char*)d_ws;
    void* args[] = {&a};
    hipError_t e = hipLaunchCooperativeKernel((const void*)fwd_megakernel, dim3(grid), dim3(NTHREADS), args, LDS_BYTES, stream);
    if (e != hipSuccess) fprintf(stderr, "cooperative launch failed: %s (grid %d)\n", hipGetErrorString(e), grid);
}
```
